# Optimizing an MI355X kernel written in HIP

```python
import math
import jax, jax.numpy as jnp
from jax import lax
import numpy as np

D_MODEL = 1024
BATCH = 16
SEQ = 256
DEPTH = 4
DEC_BATCH = 4
DEC_SEQ = 1024
PAST_LEN = 256

GRID_W = 64
DA_HEADS = 4
DA_HD = 64
DA_VD = 2 * DA_HD
DA_W = DA_HEADS * DA_VD
QBLK = 128
ROPE_THETA = 10000.0
ML_HEADS = 4
ML_HD = 128
ML_W = ML_HEADS * ML_HD
ML_CHUNK = 128
SG_GROUPS = 4
SG_CHUNK = 128
SG_W = 512
SG_GD = SG_W // SG_GROUPS
N_BRANCH = 3
BR_W = 512
D_FF = 2816
CONV_W = 3
EPS = 1e-6
NEG = -1e30
IN_SPLITS = (DA_W, 2 * DA_W, 3 * DA_W,
             3 * DA_W + ML_W, 3 * DA_W + 2 * ML_W, 3 * DA_W + 3 * ML_W, 3 * DA_W + 4 * ML_W,
             3 * DA_W + 4 * ML_W + 4 * ML_HEADS,
             3 * DA_W + 4 * ML_W + 4 * ML_HEADS + 2 * SG_W)
N_IN = 3 * DA_W + 4 * ML_W + 4 * ML_HEADS + 2 * SG_W + N_BRANCH * D_MODEL

kernel_name = 'hybrid_diffusion_prefix_trunk_step'


def rmsnorm(x, g=None):
    xf = x.astype(jnp.float32)
    y = xf * lax.rsqrt(jnp.mean(xf * xf, axis=-1, keepdims=True) + EPS)
    if g is not None:
        y = y * g.astype(jnp.float32)
    return y.astype(x.dtype)


def layernorm(x, g):
    xf = x.astype(jnp.float32)
    xc = xf - jnp.mean(xf, axis=-1, keepdims=True)
    y = xc * lax.rsqrt(jnp.mean(xc * xc, axis=-1, keepdims=True) + EPS) * g.astype(jnp.float32)
    return y.astype(x.dtype)


def dwconv3(x, w, b):
    T = x.shape[1]
    xp = jnp.pad(x, ((0, 0), (1, 1), (0, 0)))
    return xp[:, :T] * w[0] + xp[:, 1:T + 1] * w[1] + xp[:, 2:] * w[2] + b


def to_heads(a, n_heads):
    B, T, W = a.shape
    return a.reshape(B, T, n_heads, W // n_heads).transpose(0, 2, 1, 3)


def from_heads(a):
    B, H, T, Dh = a.shape
    return a.transpose(0, 2, 1, 3).reshape(B, T, H * Dh)


def axial_rope_tables(rows):
    t = jnp.arange(rows * GRID_W)
    row = (t // GRID_W).astype(jnp.float32)
    col = (t % GRID_W).astype(jnp.float32)
    nf = DA_HD // 4
    inv = ROPE_THETA ** (-jnp.arange(nf, dtype=jnp.float32) / nf)
    ang = jnp.stack([row[:, None] * inv, col[:, None] * inv], axis=1)
    return jnp.cos(ang), jnp.sin(ang)


def apply_axial_rope(x, cos, sin):
    nf = DA_HD // 4
    xs = x.reshape(x.shape[:-1] + (2, 2, 2, nf))
    x1, x2 = xs[..., 0, :], xs[..., 1, :]
    c = cos[:, None].astype(x.dtype)
    s = sin[:, None].astype(x.dtype)
    out = jnp.stack([x1 * c - x2 * s, x1 * s + x2 * c], axis=-2)
    return out.reshape(x.shape)


def diff_attention(q, k, v, lam):
    B, H, Tq, _ = q.shape
    nb = Tq // QBLK
    qb = jnp.moveaxis(q.reshape(B, H, nb, QBLK, 2 * DA_HD), 2, 0)
    k1, k2 = k[..., :DA_HD], k[..., DA_HD:]
    scale = DA_HD ** -0.5

    def block(qblk):
        q1, q2 = qblk[..., :DA_HD], qblk[..., DA_HD:]
        p1 = jax.nn.softmax((jnp.einsum('bhqd,bhkd->bhqk', q1, k1) * scale).astype(jnp.float32), axis=-1)
        p2 = jax.nn.softmax((jnp.einsum('bhqd,bhkd->bhqk', q2, k2) * scale).astype(jnp.float32), axis=-1)
        a = (p1 - lam * p2).astype(v.dtype)
        return jnp.einsum('bhqk,bhkv->bhqv', a, v)

    o = lax.map(block, qb)
    return jnp.moveaxis(o, 0, 2).reshape(B, H, Tq, DA_VD)


def mlstm_chunkwise(q, k, v, i_pre, logf, init):
    B, H, T, Dh = q.shape
    nc = T // ML_CHUNK

    def chunks(a):
        return jnp.moveaxis(a.reshape((B, H, nc, ML_CHUNK) + a.shape[3:]), 2, 0)

    causal = jnp.tril(jnp.ones((ML_CHUNK, ML_CHUNK), dtype=bool))

    def step(carry, inp):
        C, n, m = carry
        qc, kc, vc, ic, fc = inp
        b = jnp.cumsum(fc, axis=-1)
        log_w = jnp.where(causal, b[..., :, None] - b[..., None, :] + ic[..., None, :], NEG)
        inter = b + m[..., None]
        m_t = jnp.maximum(inter, jnp.max(log_w, axis=-1))
        w = jnp.exp(log_w - m_t[..., None])
        s_inter = jnp.exp(inter - m_t)
        qk = jnp.einsum('bhtd,bhsd->bhts', qc, kc) * w
        num = jnp.einsum('bhts,bhsv->bhtv', qk, vc) + s_inter[..., None] * jnp.einsum('bhtd,bhdv->bhtv', qc, C)
        den = jnp.sum(qk, axis=-1) + s_inter * jnp.einsum('bhtd,bhd->bht', qc, n)
        h = num / jnp.maximum(jnp.abs(den), jnp.exp(-m_t))[..., None]
        m_new = m_t[..., -1]
        g = jnp.exp(b[..., -1:] - b + ic - m_new[..., None])
        decay = jnp.exp(b[..., -1] + m - m_new)
        C_new = decay[..., None, None] * C + jnp.einsum('bhs,bhsd,bhsv->bhdv', g, kc, vc)
        n_new = decay[..., None] * n + jnp.einsum('bhs,bhsd->bhd', g, kc)
        return (C_new, n_new, m_new), h

    state, hs = lax.scan(step, init, (chunks(q), chunks(k), chunks(v), chunks(i_pre), chunks(logf)))
    return jnp.moveaxis(hs, 0, 2).reshape(B, H, T, Dh), state


def token_mixer(h, l, P, rope, ctx):
    B, T, _ = h.shape
    z = h @ P['w_in'][l]
    da_q, da_k, da_v, ml_q, ml_k, ml_v, ml_o, ml_g, sg_uv, gate_pre = jnp.split(z, IN_SPLITS, axis=-1)

    q = to_heads(da_q, DA_HEADS)
    k = to_heads(da_k, DA_HEADS)
    v = to_heads(da_v, DA_HEADS)
    if rope is not None:
        q = apply_axial_rope(q, rope[0], rope[1])
        k = apply_axial_rope(k, rope[0], rope[1])
    if ctx is None:
        k_all, v_all = k, v
    else:
        k_all = jnp.concatenate([ctx[0].astype(k.dtype), k], axis=2)
        v_all = jnp.concatenate([ctx[1].astype(v.dtype), v], axis=2)
    lq1, lk1, lq2, lk2 = P['da_lambda'][l].astype(jnp.float32)
    lam_init = 0.8 - 0.6 * math.exp(-0.3 * l)
    lam = jnp.exp(jnp.sum(lq1 * lk1)) - jnp.exp(jnp.sum(lq2 * lk2)) + lam_init
    o = diff_attention(q, k_all, v_all, lam)
    y_da = from_heads(rmsnorm(o, P['da_norm_g'][l]) * (1.0 - lam_init))

    qk = jax.nn.silu(dwconv3(jnp.concatenate([ml_q, ml_k], axis=-1), P['ml_conv_w'][l], P['ml_conv_b'][l]))
    mq = to_heads(qk[..., :ML_W], ML_HEADS).astype(jnp.float32)
    mk = to_heads(qk[..., ML_W:], ML_HEADS).astype(jnp.float32) * (ML_HD ** -0.5)
    mv = to_heads(ml_v, ML_HEADS).astype(jnp.float32)
    gp = (ml_g.reshape(B, T, 4, ML_HEADS).astype(jnp.float32)
          + P['ml_gate_b'][l].astype(jnp.float32)).transpose(2, 0, 3, 1)
    i_fw, i_bw = gp[0], gp[1]
    lf_fw, lf_bw = jax.nn.log_sigmoid(gp[2]), jax.nn.log_sigmoid(gp[3])
    if ctx is None:
        zero_state = (jnp.zeros((B, ML_HEADS, ML_HD, ML_HD), jnp.float32),
                      jnp.zeros((B, ML_HEADS, ML_HD), jnp.float32),
                      jnp.zeros((B, ML_HEADS), jnp.float32))
        init_fw, init_bw = zero_state, zero_state
    else:
        C0, n0, m0 = ctx[2].astype(jnp.float32), ctx[3].astype(jnp.float32), ctx[4].astype(jnp.float32)
        init_fw = (C0[:, 0], n0[:, 0], m0[:, 0])
        init_bw = (C0[:, 1], n0[:, 1], m0[:, 1])
    h_fw, st_fw = mlstm_chunkwise(mq, mk, mv, i_fw, lf_fw, init_fw)
    h_bw_r, st_bw = mlstm_chunkwise(jnp.flip(mq, 2), jnp.flip(mk, 2), jnp.flip(mv, 2),
                                    jnp.flip(i_bw, 2), jnp.flip(lf_bw, 2), init_bw)
    h_ml = rmsnorm(h_fw + jnp.flip(h_bw_r, 2), P['ml_norm_g'][l]).astype(h.dtype)
    y_ml = jax.nn.sigmoid(ml_o) * from_heads(h_ml)

    zz = jax.nn.gelu(sg_uv)
    u = zz[..., :SG_W]
    sv = layernorm(zz[..., SG_W:], P['sg_norm_g'][l])
    nc = T // SG_CHUNK
    sv = sv.reshape(B, nc, SG_CHUNK, SG_GROUPS, SG_GD)
    sv = jnp.einsum('gpq,bnqgc->bnpgc', P['sg_w'][l], sv) + P['sg_b'][l].T[:, :, None]
    y_sg = u * sv.reshape(B, T, SG_W)

    br = jnp.stack([y_da, y_ml, y_sg], axis=2)
    proj = jnp.einsum('btnc,ncd->btnd', br, P['w_branch'][l])
    gates = jax.nn.sigmoid(gate_pre).reshape(B, T, N_BRANCH, D_MODEL)
    out = jnp.sum(gates * proj, axis=2) @ P['w_out'][l]
    if ctx is None:
        ctx_out = (k, v,
                   jnp.stack([st_fw[0], st_bw[0]], axis=1),
                   jnp.stack([st_fw[1], st_bw[1]], axis=1),
                   jnp.stack([st_fw[2], st_bw[2]], axis=1))
    else:
        ctx_out = None
    return out, ctx_out


def trunk_layer(x, cond, l, P, rope, ctx):
    mod = (jax.nn.silu(cond) @ P['w_mod'][l] + P['b_mod'][l])[:, None, :]
    sh1, sc1, g1, sh2, sc2, g2 = jnp.split(mod, 6, axis=-1)
    h = rmsnorm(x) * (1.0 + sc1) + sh1
    mix, ctx_out = token_mixer(h, l, P, rope, ctx)
    x = x + g1 * mix
    h = rmsnorm(x) * (1.0 + sc2) + sh2
    u = dwconv3(h @ P['w_up'][l], P['ffn_conv_w'][l], P['ffn_conv_b'][l])
    x = x + g2 * ((jax.nn.silu(u[..., :D_FF]) * u[..., D_FF:]) @ P['w_down'][l])
    return x, ctx_out


def setup_inputs(seed: int = 0) -> dict:
    key = jax.random.key(seed)
    ks = jax.random.split(key, 32)

    def nrm(k, shape, scale):
        return scale * jax.random.normal(k, shape, jnp.float32)

    L = DEPTH
    return {
        'x_prompt': nrm(ks[0], (BATCH, SEQ, D_MODEL), 1.0),
        'x_sample': nrm(ks[1], (DEC_BATCH, DEC_SEQ, D_MODEL), 1.0),
        'c': nrm(ks[2], (DEC_BATCH, D_MODEL), 1.0),
        'cache_k': nrm(ks[3], (DEC_BATCH, L, DA_HEADS, PAST_LEN, 2 * DA_HD), 1.0),
        'cache_v': nrm(ks[4], (DEC_BATCH, L, DA_HEADS, PAST_LEN, DA_VD), 1.0),
        'state_C': nrm(ks[5], (DEC_BATCH, L, 2, ML_HEADS, ML_HD, ML_HD), 0.1),
        'state_n': nrm(ks[6], (DEC_BATCH, L, 2, ML_HEADS, ML_HD), 0.1),
        'state_m': 1.0 + nrm(ks[7], (DEC_BATCH, L, 2, ML_HEADS), 0.5),
        'c_ctx': nrm(ks[8], (D_MODEL,), 1.0),
        'w_mod': nrm(ks[9], (L, D_MODEL, 6 * D_MODEL), D_MODEL ** -0.5),
        'b_mod': nrm(ks[10], (L, 6 * D_MODEL), 0.01),
        'w_in': nrm(ks[11], (L, D_MODEL, N_IN), D_MODEL ** -0.5),
        'da_lambda': nrm(ks[12], (L, 4, DA_HD), 0.1),
        'da_norm_g': 1.0 + nrm(ks[13], (L, DA_VD), 0.01),
        'ml_conv_w': nrm(ks[14], (L, CONV_W, 2 * ML_W), CONV_W ** -0.5),
        'ml_conv_b': nrm(ks[15], (L, 2 * ML_W), 0.01),
        'ml_gate_b': jnp.concatenate([nrm(ks[16], (L, 2, ML_HEADS), 0.1),
                                      3.0 + nrm(ks[17], (L, 2, ML_HEADS), 0.1)], axis=1),
        'ml_norm_g': 1.0 + nrm(ks[18], (L, ML_HD), 0.01),
        'sg_norm_g': 1.0 + nrm(ks[19], (L, SG_W), 0.01),
        'sg_w': nrm(ks[20], (L, SG_GROUPS, SG_CHUNK, SG_CHUNK), SG_CHUNK ** -0.5),
        'sg_b': 1.0 + nrm(ks[21], (L, SG_GROUPS, SG_CHUNK), 0.01),
        'w_branch': nrm(ks[22], (L, N_BRANCH, BR_W, D_MODEL), BR_W ** -0.5),
        'w_out': nrm(ks[23], (L, D_MODEL, D_MODEL), D_MODEL ** -0.5),
        'w_up': nrm(ks[24], (L, D_MODEL, 2 * D_FF), D_MODEL ** -0.5),
        'ffn_conv_w': nrm(ks[25], (L, CONV_W, 2 * D_FF), CONV_W ** -0.5),
        'ffn_conv_b': nrm(ks[26], (L, 2 * D_FF), 0.01),
        'w_down': nrm(ks[27], (L, D_FF, D_MODEL), D_FF ** -0.5),
        'final_g': 1.0 + nrm(ks[28], (D_MODEL,), 0.01),
    }


def reference(x_prompt, x_sample, c, cache_k, cache_v, state_C, state_n, state_m, c_ctx,
              w_mod, b_mod, w_in, da_lambda, da_norm_g, ml_conv_w, ml_conv_b, ml_gate_b,
              ml_norm_g, sg_norm_g, sg_w, sg_b, w_branch, w_out, w_up, ffn_conv_w, ffn_conv_b,
              w_down, final_g):
    P = {'w_mod': w_mod, 'b_mod': b_mod, 'w_in': w_in, 'da_lambda': da_lambda, 'da_norm_g': da_norm_g,
         'ml_conv_w': ml_conv_w, 'ml_conv_b': ml_conv_b, 'ml_gate_b': ml_gate_b, 'ml_norm_g': ml_norm_g,
         'sg_norm_g': sg_norm_g, 'sg_w': sg_w, 'sg_b': sg_b, 'w_branch': w_branch, 'w_out': w_out,
         'w_up': w_up, 'ffn_conv_w': ffn_conv_w, 'ffn_conv_b': ffn_conv_b, 'w_down': w_down}

    xp = x_prompt
    ks_, vs_, Cs_, ns_, ms_ = [], [], [], [], []
    for l in range(DEPTH):
        xp, (k_l, v_l, C_l, n_l, m_l) = trunk_layer(xp, c_ctx[None, :], l, P, None, None)
        ks_.append(k_l)
        vs_.append(v_l)
        Cs_.append(C_l)
        ns_.append(n_l)
        ms_.append(m_l)
    y_prompt = rmsnorm(xp, final_g)
    new_cache_k = jnp.stack(ks_, axis=1)
    new_cache_v = jnp.stack(vs_, axis=1)
    new_state_C = jnp.stack(Cs_, axis=1).astype(x_prompt.dtype)
    new_state_n = jnp.stack(ns_, axis=1).astype(x_prompt.dtype)
    new_state_m = jnp.stack(ms_, axis=1).astype(x_prompt.dtype)

    rows = x_sample.shape[1] // GRID_W
    rope = axial_rope_tables(rows)
    xs = x_sample
    for l in range(DEPTH):
        ctx = (cache_k[:, l], cache_v[:, l], state_C[:, l], state_n[:, l], state_m[:, l])
        xs, _ = trunk_layer(xs, c, l, P, rope, ctx)
    y_sample = rmsnorm(xs, final_g)

    return (y_prompt, y_sample, new_cache_k, new_cache_v, new_state_C, new_state_n, new_state_m)
```

```cpp
#include <hip/hip_runtime.h>
#include <hip/hip_cooperative_groups.h>
#include <cstdio>
#include <cstdint>
namespace cg = cooperative_groups;

typedef unsigned short bf16_t;
typedef short bf16x8 __attribute__((ext_vector_type(8)));
typedef short bf16x4 __attribute__((ext_vector_type(4)));
typedef float f32x4 __attribute__((ext_vector_type(4)));
typedef unsigned u32x2 __attribute__((ext_vector_type(2)));
typedef float f32x2 __attribute__((ext_vector_type(2)));

constexpr int DM = 1024, NTOK = 8192, NCTX = 4096, NL = 4;
constexpr int NIN = 7696, NINP = 7936, ZW = 7680;
constexpr int DFF = 2816, UW = 5632;
constexpr int ZQ = 0, ZK = 512, ZV = 1024, MQ = 1536, MK = 2048, MV = 2560, MO = 3072, SU = 3584, SV = 4096, GT = 4608;
constexpr int VLDS = 77824;
constexpr int LDS_BYTES = 2 * VLDS + 16;
#define VHALF (p.wave >> 2)
#define VBLK ((int)(blockIdx.x * 2) + VHALF)
#define VGRID ((int)(gridDim.x * 2))
#ifndef REP_MASK
#define REP_MASK 0
#endif

constexpr size_t SZ_WIN = (size_t)NL * NINP * 1024 * 2;
constexpr size_t SZ_WBR = (size_t)NL * 3 * 1024 * 512 * 2;
constexpr size_t SZ_WOUT = (size_t)NL * 1024 * 1024 * 2;
constexpr size_t SZ_WUP = (size_t)NL * UW * 1024 * 2;
constexpr size_t SZ_WDN = (size_t)NL * 1024 * DFF * 2;
constexpr size_t OFF_WIN = 0;
constexpr size_t OFF_WBR = OFF_WIN + SZ_WIN;
constexpr size_t OFF_WOUT = OFF_WBR + SZ_WBR;
constexpr size_t OFF_WUP = OFF_WOUT + SZ_WOUT;
constexpr size_t OFF_WDN = OFF_WUP + SZ_WUP;
constexpr size_t OFF_X = OFF_WDN + SZ_WDN;
constexpr size_t OFF_H = OFF_X + (size_t)NTOK * 1024 * 4;
constexpr size_t OFF_MRG = OFF_H + (size_t)NTOK * 1024 * 2;
constexpr size_t OFF_YDA = OFF_MRG + (size_t)NTOK * 1024 * 2;
constexpr size_t OFF_YML = OFF_YDA + (size_t)NTOK * 512 * 2;
constexpr size_t OFF_YSG = OFF_YML + (size_t)NTOK * 512 * 2;
constexpr size_t OFF_ACT = OFF_H;
constexpr size_t OFF_Z = OFF_YSG + (size_t)NTOK * 512 * 2;
constexpr size_t OFF_U = OFF_Z;
constexpr size_t OFF_GP = OFF_Z + (size_t)NTOK * ZW * 2;
constexpr size_t OFF_UC = OFF_GP + (size_t)NTOK * 16 * 4;
constexpr size_t OFF_UN = OFF_UC + (size_t)512 * 16384 * 4;
constexpr size_t OFF_USC = OFF_UN + (size_t)512 * 128 * 4;
constexpr size_t OFF_A1 = OFF_USC + 4096;
constexpr size_t OFF_MOD = OFF_A1 + (size_t)NTOK * 1024 * 2;
constexpr size_t OFF_ROPE = OFF_MOD + (size_t)NL * 5 * 6144 * 4;
constexpr size_t OFF_MQC = OFF_ROPE + 8192;
constexpr size_t OFF_MKC = OFF_MQC + (size_t)NTOK * 512 * 2;
constexpr size_t OFF_CTT = OFF_MKC + (size_t)NTOK * 512 * 2;
constexpr size_t OFF_NST = OFF_CTT + (size_t)512 * 16384 * 2;
constexpr size_t OFF_MST = OFF_NST + (size_t)512 * 128 * 4;
constexpr size_t OFF_GB = OFF_MST + 4096;
constexpr size_t OFF_VTT = OFF_GB + (size_t)512 * 384 * 4;
constexpr size_t OFF_SSP = OFF_VTT + (size_t)256 * 16384 * 2;
constexpr size_t OFF_SHW1 = OFF_SSP + (size_t)16 * NTOK * 4;
constexpr size_t OFF_SHW2 = OFF_SHW1 + (size_t)NL * 5 * NINP * 4;
constexpr size_t OFF_CKB = OFF_SHW2 + (size_t)NL * 5 * UW * 4;
constexpr size_t OFF_CVB = OFF_CKB + (size_t)2097152 * 2;
constexpr size_t OFF_BAR = OFF_CVB + (size_t)2097152 * 2;
constexpr size_t WS_NEED = OFF_BAR + 16384;

constexpr int O_YP = 0, O_YS = 4194304, O_CK = 8388608, O_CV = 16777216, O_SC = 25165824, O_SN = 33554432, O_SM = 33619968;

struct Params {
  const float *x_prompt, *x_sample, *c, *cache_k, *cache_v, *state_C, *state_n, *state_m, *c_ctx, *w_mod, *b_mod, *w_in,
      *da_lambda, *da_norm_g, *ml_conv_w, *ml_conv_b, *ml_gate_b, *ml_norm_g, *sg_norm_g, *sg_w, *sg_b, *w_branch, *w_out,
      *w_up, *ffn_conv_w, *ffn_conv_b, *w_down, *final_g;
  float* out;
  char* ws;
  int phase_begin, phase_end;
  int rep_mask, never;
  int wave, pad2;
};

__device__ __forceinline__ bf16_t f2bf(float f) { __bf16 b = (__bf16)f; return __builtin_bit_cast(bf16_t, b); }
__device__ __forceinline__ float bf2f(bf16_t h) { return __uint_as_float(((unsigned)h) << 16); }
__device__ __forceinline__ float bfs(short h) { return __uint_as_float(((unsigned)(unsigned short)h) << 16); }
__device__ __forceinline__ float siluf(float x) { return x * __builtin_amdgcn_rcpf(1.f + __builtin_amdgcn_exp2f(-1.4426950408889634f * x)); }
__device__ __forceinline__ float sigmf(float x) { return __builtin_amdgcn_rcpf(1.f + __builtin_amdgcn_exp2f(-1.4426950408889634f * x)); }
__device__ __forceinline__ float geluf(float x) { float u = 0.7978845608f * (x + 0.044715f * x * x * x); float t = 1.f - 2.f * __builtin_amdgcn_rcpf(1.f + __builtin_amdgcn_exp2f(2.8853900817779268f * u)); return 0.5f * x * (1.f + t); }
__device__ __forceinline__ float logsigf(float x) { return fminf(x, 0.f) - log1pf(__expf(-fabsf(x))); }
typedef __bf16 bf16x2n __attribute__((ext_vector_type(2)));
__device__ __forceinline__ unsigned cvtpk(float lo, float hi) { f32x2 v = {lo, hi}; bf16x2n b = __builtin_convertvector(v, bf16x2n); return __builtin_bit_cast(unsigned, b); }
__device__ __forceinline__ bf16x4 pack4(float a, float b, float c, float d) { u32x2 r; r[0] = cvtpk(a, b); r[1] = cvtpk(c, d); return __builtin_bit_cast(bf16x4, r); }
typedef unsigned u32x4 __attribute__((ext_vector_type(4)));
__device__ __forceinline__ bf16x8 pack8(f32x4 a, f32x4 b) { u32x4 r; r[0] = cvtpk(a[0], a[1]); r[1] = cvtpk(a[2], a[3]); r[2] = cvtpk(b[0], b[1]); r[3] = cvtpk(b[2], b[3]); return __builtin_bit_cast(bf16x8, r); }
__device__ __forceinline__ bf16x8 cat4(bf16x4 a, bf16x4 b) { bf16x8 r; r[0] = a[0]; r[1] = a[1]; r[2] = a[2]; r[3] = a[3]; r[4] = b[0]; r[5] = b[1]; r[6] = b[2]; r[7] = b[3]; return r; }
__device__ __forceinline__ bf16x8 ld_f32x8_bf(const float* p) { f32x4 a = *(const f32x4*)p, b = *(const f32x4*)(p + 4); return pack8(a, b); }
typedef short s4v_t __attribute__((ext_vector_type(4)));
__device__ __forceinline__ bf16x4 lds_tr4(const bf16_t* p) { return __builtin_amdgcn_ds_read_tr16_b64_v4i16((__attribute__((address_space(3))) s4v_t*)p); }
#define MFMA(a, b, c) __builtin_amdgcn_mfma_f32_16x16x32_bf16((a), (b), (c), 0, 0, 0)
__device__ __forceinline__ int lane_id() { return (int)__builtin_amdgcn_mbcnt_hi(~0u, __builtin_amdgcn_mbcnt_lo(~0u, 0u)); }
#define opaque_tid() opaque_tid_(p.wave)
__device__ __forceinline__ int opaque_tid_(int wave) { int t = ((wave & 3) << 6) | lane_id(); asm volatile("" : "+v"(t)); return t; }
__device__ __forceinline__ int real_tid_(int wave) { int t = (wave << 6) | lane_id(); asm volatile("" : "+v"(t)); return t; }
__device__ __forceinline__ char* opaque_ptr(char* p) { asm volatile("" : "+s"(p)); return p; }
__device__ __forceinline__ f32x4 zero4() { float z; asm volatile("v_mov_b32 %0, 0" : "=v"(z)); f32x4 r = {z, z, z, z}; return r; }
__device__ __forceinline__ bf16x8 zero8() { f32x4 z = zero4(); return __builtin_bit_cast(bf16x8, z); }
__device__ __forceinline__ int cond_of(int row) { return row < NCTX ? 0 : 1 + ((row - NCTX) >> 10); }


#define XB_TMO      128
#define XB_XCNT(j)  (256  + 64 * (j))
#define XB_XSUB(j)  (1280 + 64 * (j))
#define XB_XGEN(j)  (2304 + 64 * (j))
#define XB_TOP      3328
#define XB_TOPGEN   3392
#define XCD_BAR_WORDS 3456
#define XB_SPIN_CAP (1u << 20)
#define LAS __attribute__((address_space(3)))
__device__ __forceinline__ unsigned xb_ld(unsigned* p)              { return __hip_atomic_load(p, __ATOMIC_RELAXED, __HIP_MEMORY_SCOPE_AGENT); }
__device__ __forceinline__ unsigned xb_add(unsigned* p, unsigned v) { return __hip_atomic_fetch_add(p, v, __ATOMIC_RELAXED, __HIP_MEMORY_SCOPE_AGENT); }
__device__ __forceinline__ unsigned xb_xcc_id() { return (unsigned)__builtin_amdgcn_s_getreg((3 << 11) | 20) & 0xFu; }
#define XB_SPIN(cond, bar) do { unsigned _sp = 0; while (cond) { __builtin_amdgcn_s_sleep(1); \
    if ((++_sp & 255u) == 0u) { if (xb_ld(&(bar)[XB_TMO])) break; if (_sp > XB_SPIN_CAP) { atomicAdd(&(bar)[XB_TMO], 1u); break; } } } } while (0)
struct XcdBarrier { unsigned* bar; unsigned x; volatile LAS unsigned* st; };
__device__ __forceinline__ XcdBarrier xcd_barrier_post(unsigned* bar, volatile LAS unsigned* st) {
    XcdBarrier b; b.bar = bar; b.x = xb_xcc_id(); b.st = st;
    if (threadIdx.x == 0) (void)xb_add(&bar[XB_XCNT(b.x)], 1u);
    return b;
}
__device__ __forceinline__ void xcd_barrier_complete(unsigned* bar, unsigned x, unsigned& nloc, unsigned& nx) {
    const unsigned G = gridDim.x * gridDim.y * gridDim.z;
    unsigned sum, cnt, mine, sp = 0u;
    for (;;) {
        sum = 0u; cnt = 0u; mine = 0u;
#pragma unroll
        for (unsigned j = 0; j < 16; ++j) { const unsigned c = xb_ld(&bar[XB_XCNT(j)]); sum += c; cnt += (c > 0u) ? 1u : 0u; mine = (j == x) ? c : mine; }
        if (sum == G) break;
        __builtin_amdgcn_s_sleep(1);
        if ((++sp & 255u) == 0u) { if (xb_ld(&bar[XB_TMO])) break; if (sp > XB_SPIN_CAP) { atomicAdd(&bar[XB_TMO], 1u); break; } }
    }
    nloc = mine > 0u ? mine : 1u; nx = cnt > 0u ? cnt : 1u;
}
__device__ __forceinline__ void xcd_barrier(const XcdBarrier& b) {
    asm volatile("s_waitcnt vmcnt(0)" ::: "memory");
    __syncthreads();
    if (threadIdx.x == 0) {
        unsigned* bar = b.bar;
        __builtin_amdgcn_s_waitcnt(0);
        unsigned nloc = b.st[0], nx = b.st[1];
        if (nloc == 0u) { xcd_barrier_complete(bar, b.x, nloc, nx); b.st[0] = nloc; b.st[1] = nx; }
        const unsigned old = xb_add(&bar[XB_XSUB(b.x)], 1u);
        const unsigned gen = old / nloc;
        if (old + 1u == (gen + 1u) * nloc) {
            __builtin_amdgcn_fence(__ATOMIC_RELEASE, "agent");
            asm volatile("s_waitcnt vmcnt(0)" ::: "memory");
            const unsigned og = xb_add(&bar[XB_TOP], 1u);
            const unsigned tg = og / nx;
            if (og + 1u == (tg + 1u) * nx) xb_add(&bar[XB_TOPGEN], 1u);
            else XB_SPIN(xb_ld(&bar[XB_TOPGEN]) == tg, bar);
            __builtin_amdgcn_fence(__ATOMIC_ACQUIRE, "agent");
            xb_add(&bar[XB_XGEN(b.x)], 1u);
            asm volatile("s_waitcnt vmcnt(0)" ::: "memory");
        } else {
            XB_SPIN(xb_ld(&bar[XB_XGEN(b.x)]) == gen, bar);
            __builtin_amdgcn_fence(__ATOMIC_ACQUIRE, "agent");
            asm volatile("s_waitcnt vmcnt(0)" ::: "memory");
        }
    }
    __syncthreads();
}

__device__ __forceinline__ int tile_off(int row, int ks, int q) { return row * 128 + ((((ks << 2) | q) ^ ((row >> 1) & 7)) << 4); }

#define WAIT_V(n) asm volatile("s_waitcnt vmcnt(" #n ")" ::: "memory")
#define RAW_BARRIER() do { asm volatile("s_waitcnt lgkmcnt(0)" ::: "memory"); __builtin_amdgcn_s_barrier(); } while (0)
__device__ __forceinline__ void gemm_mainloop(const Params& p, f32x4 (&acc)[4][4], const bf16_t* __restrict__ A, int lda, const bf16_t* __restrict__ Bt, int ldb,
                                              int m0, int n0, int K, char* lds) {
  const int tid = opaque_tid(), l = tid & 63, w = tid >> 6, wm = w >> 1, wn = w & 1, lr = l & 15, q = l >> 4;
  const int vh = p.wave >> 2;
  const int nk = K >> 6;
  const int lrow = tid >> 3;
  const int lch = (tid & 7) ^ ((lrow >> 1) & 7);
  const bf16_t* ap = A + (size_t)(m0 + lrow) * lda + lch * 8;
  const bf16_t* bp = Bt + (size_t)(n0 + lrow) * ldb + lch * 8;
  char* ldst = lds + tid * 16;
  const char* ldsB = lds - vh * VLDS;
#define GEMM_STAGE(buf, kt)                                                                                                          \
  do {                                                                                                                               \
    _Pragma("unroll") for (int i = 0; i < 4; ++i)                                                                                    \
      __builtin_amdgcn_global_load_lds((const unsigned*)(ap + (size_t)i * 32 * lda + (kt) * 64), (__attribute__((address_space(3))) unsigned*)(ldst + (buf) * 32768 + i * 4096), 16, 0, 0);         \
    if (vh == 0) {                                                                                                                   \
      _Pragma("unroll") for (int i = 0; i < 4; ++i)                                                                                  \
        __builtin_amdgcn_global_load_lds((const unsigned*)(bp + (size_t)i * 32 * ldb + (kt) * 64), (__attribute__((address_space(3))) unsigned*)(ldst + (buf) * 32768 + 16384 + i * 4096), 16, 0, 0); \
    }                                                                                                                                \
  } while (0)
  WAIT_V(0);
  GEMM_STAGE(0, 0);
  WAIT_V(0);
  RAW_BARRIER();
  if (vh == 1) RAW_BARRIER();
  for (int kt = 0; kt < nk; ++kt) {
    if (kt + 1 < nk) GEMM_STAGE((kt + 1) & 1, kt + 1);
    const char* sa = lds + (kt & 1) * 32768;
    const char* sb = ldsB + (kt & 1) * 32768 + 16384;
    bf16x8 af[2][4], bfr[2][4];
#pragma unroll
    for (int ks = 0; ks < 2; ++ks) {
#pragma unroll
      for (int mi = 0; mi < 4; ++mi) af[ks][mi] = *(const bf16x8*)(sa + tile_off(wm * 64 + mi * 16 + lr, ks, q));
#pragma unroll
      for (int ni = 0; ni < 4; ++ni) bfr[ks][ni] = *(const bf16x8*)(sb + tile_off(wn * 64 + ni * 16 + lr, ks, q));
    }
    __builtin_amdgcn_sched_barrier(0);
    RAW_BARRIER();
    __builtin_amdgcn_sched_barrier(0);
    __builtin_amdgcn_s_setprio(1);
#pragma unroll
    for (int ks = 0; ks < 2; ++ks)
#pragma unroll
      for (int mi = 0; mi < 4; ++mi)
#pragma unroll
        for (int ni = 0; ni < 4; ++ni) acc[mi][ni] = MFMA(bfr[ks][ni], af[ks][mi], acc[mi][ni]);
    __builtin_amdgcn_s_setprio(0);
    WAIT_V(0);
    __builtin_amdgcn_sched_barrier(0);
    RAW_BARRIER();
    __builtin_amdgcn_sched_barrier(0);
  }
  if (vh == 0) RAW_BARRIER();
#undef GEMM_STAGE
}

__device__ __forceinline__ int tile_off32(int row, int q) { return row * 64 + ((q ^ (((row >> 3) & 1) << 1)) << 4); }
__device__ __forceinline__ void gemm_mainloop_w(const Params& p, f32x4 (&acc)[4][8], const bf16_t* __restrict__ A, int lda, const bf16_t* __restrict__ Bt, int ldb,
                                                int m0, int n0, int K, char* lds) {
  const int tid = opaque_tid(), l = tid & 63, w = tid >> 6, wm = w >> 1, wn = w & 1, lr = l & 15, q = l >> 4;
  const int nk = K >> 5;
  const int lrow = tid >> 2;
  const int lch = (tid & 3) ^ (((lrow >> 3) & 1) << 1);
  const bf16_t* ap = A + (size_t)(m0 + lrow) * lda + lch * 8;
  const bf16_t* bp = Bt + (size_t)(n0 + lrow) * ldb + lch * 8;
  char* ldst = lds + tid * 16;
#define GEMM_STAGE_W(buf, kt)                                                                                                        \
  do {                                                                                                                               \
    _Pragma("unroll") for (int i = 0; i < 2; ++i)                                                                                    \
      __builtin_amdgcn_global_load_lds((const unsigned*)(ap + (size_t)i * 64 * lda + (kt) * 32), (__attribute__((address_space(3))) unsigned*)(ldst + (buf) * 24576 + i * 4096), 16, 0, 0);        \
    _Pragma("unroll") for (int i = 0; i < 4; ++i)                                                                                    \
      __builtin_amdgcn_global_load_lds((const unsigned*)(bp + (size_t)i * 64 * ldb + (kt) * 32), (__attribute__((address_space(3))) unsigned*)(ldst + (buf) * 24576 + 8192 + i * 4096), 16, 0, 0); \
  } while (0)
  WAIT_V(0);
  GEMM_STAGE_W(0, 0);
  GEMM_STAGE_W(1, 1);
  int buf = 0, nbuf = 2;
  for (int kt = 0; kt < nk; ++kt) {
    if (kt < nk - 1) WAIT_V(6); else WAIT_V(0);
    RAW_BARRIER();
    if (kt + 2 < nk) GEMM_STAGE_W(nbuf, kt + 2);
    const char* sa = lds + buf * 24576;
    const char* sb = sa + 8192;
    bf16x8 af[4];
#pragma unroll
    for (int mi = 0; mi < 4; ++mi) af[mi] = *(const bf16x8*)(sa + tile_off32(wm * 64 + mi * 16 + lr, q));
#pragma unroll
    for (int nh = 0; nh < 2; ++nh) {
      bf16x8 bfr[4];
#pragma unroll
      for (int ni = 0; ni < 4; ++ni) bfr[ni] = *(const bf16x8*)(sb + tile_off32(wn * 128 + (nh * 4 + ni) * 16 + lr, q));
#pragma unroll
      for (int mi = 0; mi < 4; ++mi)
#pragma unroll
        for (int ni = 0; ni < 4; ++ni) acc[mi][nh * 4 + ni] = MFMA(bfr[ni], af[mi], acc[mi][nh * 4 + ni]);
      __builtin_amdgcn_sched_barrier(0);
    }
    buf = buf == 2 ? 0 : buf + 1;
    nbuf = nbuf == 2 ? 0 : nbuf + 1;
  }
  RAW_BARRIER();
#undef GEMM_STAGE_W
}

__device__ __forceinline__ void gemm_mainloop_8w(f32x4 (&acc)[8][4], const bf16_t* __restrict__ A, int lda, const bf16_t* __restrict__ Bt, int ldb,
                                                 int m0, int n0, int K, char* lds, int wave) {
  int tid = real_tid_(wave);
  const int l = tid & 63, w = tid >> 6, wm = w >> 2, wn = w & 3, lr = l & 15, q = l >> 4;
  const int nk = K >> 6;
  const int lrow = tid >> 3;
  const int lch = (tid & 7) ^ ((lrow >> 1) & 7);
  const bf16_t* ap = A + (size_t)(m0 + lrow) * lda + lch * 8;
  const bf16_t* bp = Bt + (size_t)(n0 + lrow) * ldb + lch * 8;
  char* ldst = lds + tid * 16;
#define GEMM_STAGE_8(buf, kt)                                                                                                        \
  do {                                                                                                                               \
    _Pragma("unroll") for (int i = 0; i < 4; ++i)                                                                                    \
      __builtin_amdgcn_global_load_lds((const unsigned*)(ap + (size_t)i * 64 * lda + (kt) * 64), (__attribute__((address_space(3))) unsigned*)(ldst + (buf) * 65536 + i * 8192), 16, 0, 0);         \
    _Pragma("unroll") for (int i = 0; i < 4; ++i)                                                                                    \
      __builtin_amdgcn_global_load_lds((const unsigned*)(bp + (size_t)i * 64 * ldb + (kt) * 64), (__attribute__((address_space(3))) unsigned*)(ldst + (buf) * 65536 + 32768 + i * 8192), 16, 0, 0); \
  } while (0)
#define HALF_STEP(KS)                                                                                                                \
  do {                                                                                                                               \
    bf16x8 bfr[4], af[8];                                                                                                            \
    _Pragma("unroll") for (int ni = 0; ni < 4; ++ni) bfr[ni] = *(const bf16x8*)(sb + tile_off(wn * 64 + ni * 16 + lr, KS, q));        \
    _Pragma("unroll") for (int mi = 0; mi < 8; ++mi) af[mi] = *(const bf16x8*)(sa + tile_off(wm * 128 + mi * 16 + lr, KS, q));        \
    if (KS == 1 && wm == 1) WAIT_V(0);     \
    __builtin_amdgcn_sched_barrier(0);                                                                                               \
    RAW_BARRIER();                                                                                                                   \
    __builtin_amdgcn_sched_barrier(0);                                                                                               \
    __builtin_amdgcn_s_setprio(1);                                                                                                   \
    _Pragma("unroll") for (int mi = 0; mi < 8; ++mi)                                                                                 \
      _Pragma("unroll") for (int ni = 0; ni < 4; ++ni) acc[mi][ni] = MFMA(bfr[ni], af[mi], acc[mi][ni]);                             \
    __builtin_amdgcn_s_setprio(0);                                                                                                   \
    if (KS == 1 && wm == 0) WAIT_V(0);                                                    \
    __builtin_amdgcn_sched_barrier(0);                                                                                               \
    RAW_BARRIER();                                                                                                                   \
    __builtin_amdgcn_sched_barrier(0);                                                                                               \
  } while (0)
  WAIT_V(0);
  GEMM_STAGE_8(0, 0);
  WAIT_V(0);
  RAW_BARRIER();
  if (wm == 1) RAW_BARRIER();
  for (int kt = 0; kt < nk; ++kt) {
    if (kt + 1 < nk) GEMM_STAGE_8((kt + 1) & 1, kt + 1);
    const char* sa = lds + (kt & 1) * 65536;
    const char* sb = sa + 32768;
    HALF_STEP(0);
    HALF_STEP(1);
  }
  if (wm == 0) RAW_BARRIER();
#undef HALF_STEP
#undef GEMM_STAGE_8
}

__device__ __forceinline__ void zero_acc(f32x4 (&acc)[4][4]) {
#pragma unroll
  for (int i = 0; i < 4; ++i)
#pragma unroll
    for (int j = 0; j < 4; ++j) acc[i][j] = zero4();
}

__device__ void convert_tile(const Params& p, const float* __restrict__ W, bf16_t* __restrict__ WT, int K, int N, int tk, int tn, bool perm, char* lds) {
  float* tile = (float*)lds;
  const int tid = opaque_tid();
  const int k0 = tk * 64, n0 = tn * 128;
  __syncthreads();
  {
    const int nn = (tid & 63) * 2, kb = tid >> 6;
    f32x2 v[16];
#pragma unroll
    for (int i = 0; i < 16; ++i) {
      v[i] = (f32x2){0.f, 0.f};
      if (n0 + nn < N) v[i] = *(const f32x2*)(W + (size_t)(k0 + i * 4 + kb) * N + n0 + nn);
    }
#pragma unroll
    for (int i = 0; i < 16; ++i) { tile[(i * 4 + kb) * 129 + nn] = v[i][0]; tile[(i * 4 + kb) * 129 + nn + 1] = v[i][1]; }
  }
  __syncthreads();
#pragma unroll
  for (int i = 0; i < 4; ++i) {
    int c = tid + i * 256, nn = c >> 3, kc = c & 7;
    int n = n0 + nn;
    if (n < N) {
      int dn = n;
      if (perm) dn = (n < 3584) ? n : ((n < 3600) ? (7680 + n - 3584) : (n - 16));
      bf16x8 o;
#pragma unroll
      for (int e = 0; e < 8; ++e) o[e] = (short)f2bf(tile[(kc * 8 + e) * 129 + nn]);
      *(bf16x8*)(WT + (size_t)dn * K + k0 + kc * 8) = o;
    }
  }
}

__device__ void phase_prologue(const Params& p, char* lds) {
  char* ws = opaque_ptr(p.ws);
  const int tid = opaque_tid();
  constexpr int T_IN = 16 * 61, T_BR = 8 * 8, T_OUT = 16 * 8, T_UP = 16 * 44, T_DN = 44 * 8;
  constexpr int T_LAYER = T_IN + 3 * T_BR + T_OUT + T_UP + T_DN;
  for (int it = VBLK; it < NL * T_LAYER; it += VGRID) {
    int l = it / T_LAYER, r = it % T_LAYER;
    if (r < T_IN) {
      convert_tile(p, p.w_in + (size_t)l * 1024 * NIN, (bf16_t*)(ws + OFF_WIN) + (size_t)l * NINP * 1024, 1024, NIN, r / 61, r % 61, true, lds);
    } else if ((r -= T_IN) < 3 * T_BR) {
      int br = r / T_BR; r %= T_BR;
      convert_tile(p, p.w_branch + (size_t)(l * 3 + br) * 512 * 1024, (bf16_t*)(ws + OFF_WBR) + (size_t)(l * 3 + br) * 1024 * 512, 512, 1024, r / 8, r % 8, false, lds);
    } else if ((r -= 3 * T_BR) < T_OUT) {
      convert_tile(p, p.w_out + (size_t)l * 1024 * 1024, (bf16_t*)(ws + OFF_WOUT) + (size_t)l * 1024 * 1024, 1024, 1024, r / 8, r % 8, false, lds);
    } else if ((r -= T_OUT) < T_UP) {
      convert_tile(p, p.w_up + (size_t)l * 1024 * UW, (bf16_t*)(ws + OFF_WUP) + (size_t)l * UW * 1024, 1024, UW, r / 44, r % 44, false, lds);
    } else {
      r -= T_UP;
      convert_tile(p, p.w_down + (size_t)l * DFF * 1024, (bf16_t*)(ws + OFF_WDN) + (size_t)l * 1024 * DFF, DFF, 1024, r / 8, r % 8, false, lds);
    }
  }
  for (int i = VBLK * 256 + tid; i < 2 * 262144; i += VGRID * 256) {
    const bool isv = i >= 262144;
    const int j = isv ? i - 262144 : i;
    const float* src = (isv ? p.cache_v : p.cache_k) + (size_t)j * 8;
    *(bf16x8*)((bf16_t*)(ws + (isv ? OFF_CVB : OFF_CKB)) + (size_t)j * 8) = ld_f32x8_bf(src);
  }
  {
    const int per = (NINP - NIN) * 1024 / 8;
    for (int i = VBLK * 256 + tid; i < NL * per; i += VGRID * 256) {
      int l = i / per, c = i % per;
      bf16x8 zv = zero8();
      *(bf16x8*)((bf16_t*)(ws + OFF_WIN) + (size_t)l * NINP * 1024 + (size_t)NIN * 1024 + (size_t)c * 8) = zv;
    }
  }
  if (VBLK == 0) {
    float* rt = (float*)(ws + OFF_ROPE);
    for (int i = tid; i < 1024; i += 256) {
      int pos = i >> 4, f = i & 15;
      float inv = powf(10000.f, -(float)f / 16.f);
      float ang = (float)pos * inv;
      rt[i * 2] = cosf(ang);
      rt[i * 2 + 1] = sinf(ang);
    }
  }
  {
    float* sc = (float*)lds;
    float* red = (float*)(lds + 20480);
    float* mod = (float*)(ws + OFF_MOD);
    for (int it = VBLK; it < NL * 96; it += VGRID) {
      int l = it / 96, cb = it % 96;
      __syncthreads();
      for (int i = tid; i < 5120; i += 256) {
        int c = i >> 10, k = i & 1023;
        float v = (c == 0) ? p.c_ctx[k] : p.c[(c - 1) * 1024 + k];
        sc[i] = siluf(v);
      }
      __syncthreads();
      int kg = tid >> 6, col = cb * 64 + (tid & 63);
      float a0 = 0, a1 = 0, a2 = 0, a3 = 0, a4 = 0;
      const float* wp = p.w_mod + ((size_t)l * 1024 + kg * 256) * 6144 + col;
#pragma unroll 16
      for (int k = 0; k < 256; ++k) {
        float wv = wp[(size_t)k * 6144];
        int kk = kg * 256 + k;
        a0 += sc[kk] * wv; a1 += sc[1024 + kk] * wv; a2 += sc[2048 + kk] * wv; a3 += sc[3072 + kk] * wv; a4 += sc[4096 + kk] * wv;
      }
      int lc = tid & 63;
      red[(kg * 5 + 0) * 64 + lc] = a0; red[(kg * 5 + 1) * 64 + lc] = a1; red[(kg * 5 + 2) * 64 + lc] = a2; red[(kg * 5 + 3) * 64 + lc] = a3; red[(kg * 5 + 4) * 64 + lc] = a4;
      __syncthreads();
      if (tid < 64) {
        float b = p.b_mod[l * 6144 + col];
#pragma unroll
        for (int c = 0; c < 5; ++c) {
          float s = red[(0 * 5 + c) * 64 + tid] + red[(1 * 5 + c) * 64 + tid] + red[(2 * 5 + c) * 64 + tid] + red[(3 * 5 + c) * 64 + tid];
          mod[(size_t)(l * 5 + c) * 6144 + col] = s + b;
        }
      }
    }
  }
}

__device__ void phase_norm(const Params& p, int l, int which  , bool first) {
  char* ws = opaque_ptr(p.ws);
  float* x = (float*)(ws + OFF_X);
  bf16_t* H = (bf16_t*)(ws + OFF_H);
  const float* mod = (const float*)(ws + OFF_MOD);
  const int tid = opaque_tid();
  const int lane = tid & 63, w = tid >> 6;
  for (int row = VBLK * 4 + w; row < NTOK; row += VGRID * 4) {
    const float* src = first ? (row < NCTX ? p.x_prompt + (size_t)row * 1024 : p.x_sample + (size_t)(row - NCTX) * 1024) : x + (size_t)row * 1024;
    f32x4 v[4];
    float ss = 0.f;
#pragma unroll
    for (int i = 0; i < 4; ++i) { v[i] = *(const f32x4*)(src + i * 256 + lane * 4); ss += v[i][0] * v[i][0] + v[i][1] * v[i][1] + v[i][2] * v[i][2] + v[i][3] * v[i][3]; }
#pragma unroll
    for (int o = 1; o < 64; o <<= 1) ss += __shfl_xor(ss, o);
    float rstd = rsqrtf(ss * (1.f / 1024.f) + 1e-6f);
    if (which == 2) {
      float* dst = p.out + (size_t)row * 1024;
#pragma unroll
      for (int i = 0; i < 4; ++i) {
        f32x4 g = *(const f32x4*)(p.final_g + i * 256 + lane * 4);
        f32x4 o = {v[i][0] * rstd * g[0], v[i][1] * rstd * g[1], v[i][2] * rstd * g[2], v[i][3] * rstd * g[3]};
        *(f32x4*)(dst + i * 256 + lane * 4) = o;
      }
    } else {
      const float* mrow = mod + (size_t)(l * 5 + cond_of(row)) * 6144 + (which == 0 ? 0 : 3072);
#pragma unroll
      for (int i = 0; i < 4; ++i) {
        int col = i * 256 + lane * 4;
        f32x4 sh = *(const f32x4*)(mrow + col), sc = *(const f32x4*)(mrow + 1024 + col);
        *(bf16x4*)(H + (size_t)row * 1024 + col) = pack4(v[i][0] * rstd * (1.f + sc[0]) + sh[0], v[i][1] * rstd * (1.f + sc[1]) + sh[1],
                                                         v[i][2] * rstd * (1.f + sc[2]) + sh[2], v[i][3] * rstd * (1.f + sc[3]) + sh[3]);
        if (first) *(f32x4*)(x + (size_t)row * 1024 + col) = v[i];
      }
    }
  }
}

__device__ void phase_init(const Params& p) {
  char* ws = p.ws;
  float* x = (float*)(ws + OFF_X);
  bf16_t* A1 = (bf16_t*)(ws + OFF_A1);
  float* ssp = (float*)(ws + OFF_SSP);
  const float* mod = (const float*)(ws + OFF_MOD);
  const int tid = opaque_tid();
  const int lane = tid & 63, w = tid >> 6;
  for (int row = VBLK * 4 + w; row < NTOK; row += VGRID * 4) {
    const float* src = row < NCTX ? p.x_prompt + (size_t)row * 1024 : p.x_sample + (size_t)(row - NCTX) * 1024;
    const float* mrow = mod + (size_t)(cond_of(row)) * 6144 + 1024;
    float ss = 0.f;
#pragma unroll
    for (int i = 0; i < 4; ++i) {
      int col = i * 256 + lane * 4;
      f32x4 v = *(const f32x4*)(src + col);
      ss += v[0] * v[0] + v[1] * v[1] + v[2] * v[2] + v[3] * v[3];
      f32x4 sc = *(const f32x4*)(mrow + col);
      *(f32x4*)(x + (size_t)row * 1024 + col) = v;
      *(bf16x4*)(A1 + (size_t)row * 1024 + col) = pack4(v[0] * (1.f + sc[0]), v[1] * (1.f + sc[1]), v[2] * (1.f + sc[2]), v[3] * (1.f + sc[3]));
    }
#pragma unroll
    for (int o = 1; o < 64; o <<= 1) ss += __shfl_xor(ss, o);
    if (lane < 8) ssp[(size_t)lane * NTOK + row] = lane == 0 ? ss : 0.f;
  }
  {
    const int lr = lane & 15, q = lane >> 4;
    constexpr int TPL = (NINP + UW) / 16;
    for (int ct = VBLK * 4 + w; ct < NL * TPL; ct += VGRID * 4) {
      const int l = ct / TPL, r = ct % TPL;
      const bool up = r >= NINP / 16;
      const int n0 = up ? (r - NINP / 16) * 16 : r * 16;
      const bf16_t* wr = (up ? (const bf16_t*)(ws + OFF_WUP) + ((size_t)l * UW + n0 + lr) * 1024 : (const bf16_t*)(ws + OFF_WIN) + ((size_t)l * NINP + n0 + lr) * 1024) + q * 8;
      const float* shb = mod + (size_t)(l * 5 + (lr < 5 ? lr : 4)) * 6144 + (up ? 3072 : 0) + q * 8;
      f32x4 acc = zero4();
#pragma unroll 4
      for (int ks = 0; ks < 32; ++ks) {
        bf16x8 bfrag = *(const bf16x8*)(wr + ks * 32);
        bf16x8 afrag = ld_f32x8_bf(shb + ks * 32);
        if (lr >= 5) afrag = zero8();
        acc = MFMA(afrag, bfrag, acc);
      }
      float* outp = up ? (float*)(ws + OFF_SHW2) + (size_t)(l * 5) * UW + n0 + lr : (float*)(ws + OFF_SHW1) + (size_t)(l * 5) * NINP + n0 + lr;
      const int W = up ? UW : NINP;
      if (q == 0) { outp[0] = acc[0]; outp[W] = acc[1]; outp[2 * W] = acc[2]; outp[3 * W] = acc[3]; }
      if (q == 1) outp[4 * W] = acc[0];
    }
  }
}

__device__ __forceinline__ float row_rstd(const float* ssp, int m) {
  float s = 0.f;
#pragma unroll
  for (int j = 0; j < 8; ++j) s += ssp[(size_t)j * NTOK + m];
  return rsqrtf(s * (1.f / 1024.f) + 1e-6f);
}

__device__ void phase_inproj(const Params& p, int l, char* lds_all) {
  char* ws = opaque_ptr(p.ws);
  const bf16_t* H = (const bf16_t*)(ws + OFF_A1);
  const bf16_t* Wt = (const bf16_t*)(ws + OFF_WIN) + (size_t)l * NINP * 1024;
  bf16_t* z = (bf16_t*)(ws + OFF_Z);
  float* gp = (float*)(ws + OFF_GP);
  const float* rope = (const float*)(ws + OFF_ROPE);
  int tid = real_tid_(p.wave);
  const int lane = tid & 63, w = tid >> 6, wm = w >> 2, wn = w & 3, lr = lane & 15, q = lane >> 4;
  float* rs_lds = (float*)(lds_all + 131072);
  float* sh_lds = (float*)(lds_all + 131072 + 1024);
  int par = 0, cur_mt = -1;
  for (int it = blockIdx.x; it < 32 * 31; it += gridDim.x, par ^= 1) {
    const int ntw = it >> 5, mt = it & 31;
    const int m0 = mt * 256, n0 = ntw * 256;
    if (mt != cur_mt) {
      __syncthreads();
      if (tid < 256) rs_lds[tid] = row_rstd((const float*)(ws + OFF_SSP), m0 + tid);
      cur_mt = mt;
    }
    if (tid < 64) *(f32x4*)(sh_lds + par * 256 + tid * 4) = *(const f32x4*)((const float*)(ws + OFF_SHW1) + (size_t)(l * 5 + cond_of(m0)) * NINP + n0 + tid * 4);
    f32x4 acc[8][4];
#pragma unroll
    for (int i = 0; i < 8; ++i)
#pragma unroll
      for (int j = 0; j < 4; ++j) acc[i][j] = zero4();
    gemm_mainloop_8w(acc, H, 1024, Wt, 1024, m0, n0, 1024, lds_all, p.wave);
    int lro = lr; asm volatile("" : "+v"(lro));
    const bool lat = m0 >= NCTX;
    const int nc0 = n0 + wn * 64;
    const int nt = nc0 >> 7, sub = (nc0 >> 6) & 1;
    const bool active = !(nt > 60 || (nt == 60 && sub == 1));
    if (active) {
      const float* shl = sh_lds + par * 256 + wn * 64 + q * 4;
      if (nt == 60) {
#pragma unroll
        for (int mi = 0; mi < 8; ++mi) {
          const int m = m0 + wm * 128 + mi * 16 + lro;
          const float rs = rs_lds[wm * 128 + mi * 16 + lro];
          f32x4 sv = *(const f32x4*)shl;
          f32x4 o;
#pragma unroll
          for (int r = 0; r < 4; ++r) {
            int j = q * 4 + r;
            float v = acc[mi][0][r] * rs + sv[r] + p.ml_gate_b[l * 16 + j];
            o[r] = (j < 8) ? v : logsigf(v);
          }
          *(f32x4*)(gp + (size_t)m * 16 + q * 4) = o;
        }
      } else {
        const int mode = (nt < 24) ? 0 : ((nt < 28) ? 1 : ((nt < 36) ? 2 : 1));
        const bool do_rope = lat && nt < 8;
        const bool do_cache = !lat && nt >= 4 && nt < 12;
        float* cdst = p.out + ((nt < 8) ? O_CK : O_CV);
        const int hh = (nt - 4) & 3;
        char* stg = lds_all + w * 8192;
#pragma unroll
        for (int mh = 0; mh < 2; ++mh) {
#pragma unroll
          for (int mq = 0; mq < 4; ++mq) {
            const int mi = mh * 4 + mq;
            const int m = m0 + wm * 128 + mi * 16 + lro;
            const float rs = rs_lds[wm * 128 + mi * 16 + lro];
#pragma unroll
            for (int ni = 0; ni < 4; ++ni) {
              f32x4 sv = *(const f32x4*)(shl + ni * 16);
              acc[mi][ni][0] = acc[mi][ni][0] * rs + sv[0]; acc[mi][ni][1] = acc[mi][ni][1] * rs + sv[1];
              acc[mi][ni][2] = acc[mi][ni][2] * rs + sv[2]; acc[mi][ni][3] = acc[mi][ni][3] * rs + sv[3];
            }
            if (do_rope) {
              const int t = (m - NCTX) & 1023;
#pragma unroll
              for (int a = 0; a < 2; ++a) {
                const int pos = (a == 0) ? (t >> 6) : (t & 63);
#pragma unroll
                for (int r = 0; r < 4; ++r) {
                  const int f = q * 4 + r;
                  const float c = rope[(pos * 16 + f) * 2], sn = rope[(pos * 16 + f) * 2 + 1];
                  const float x1 = acc[mi][2 * a][r], x2 = acc[mi][2 * a + 1][r];
                  acc[mi][2 * a][r] = x1 * c - x2 * sn;
                  acc[mi][2 * a + 1][r] = x1 * sn + x2 * c;
                }
              }
            }
            if (do_cache) {
              const int b = m >> 8, t = m & 255;
              float* rowp = cdst + ((size_t)((b * 4 + l) * 4 + hh) * 256 + t) * 128 + sub * 64 + q * 4;
#pragma unroll
              for (int ni = 0; ni < 4; ++ni) *(f32x4*)(rowp + ni * 16) = acc[mi][ni];
            }
#pragma unroll
            for (int ni = 0; ni < 4; ++ni) {
              f32x4 v = acc[mi][ni];
              if (mode == 1) { v[0] = sigmf(v[0]); v[1] = sigmf(v[1]); v[2] = sigmf(v[2]); v[3] = sigmf(v[3]); }
              else if (mode == 2) { v[0] = geluf(v[0]); v[1] = geluf(v[1]); v[2] = geluf(v[2]); v[3] = geluf(v[3]); }
              *(bf16x4*)(stg + (mq * 16 + lro) * 128 + ((((ni << 1) | (q >> 1)) ^ (lro & 7)) << 4) + ((q & 1) << 3)) = pack4(v[0], v[1], v[2], v[3]);
            }
            __builtin_amdgcn_sched_barrier(0);
          }
#pragma unroll
          for (int i = 0; i < 8; ++i) {
            const int r = i * 8 + (lane >> 3), c = lane & 7;
            bf16x8 v = *(const bf16x8*)(stg + r * 128 + ((c ^ (r & 7)) << 4));
            *(bf16x8*)(z + (size_t)(m0 + wm * 128 + mh * 64 + r) * ZW + nc0 + c * 8) = v;
          }
        }
      }
    }
    __syncthreads();
  }
}

__device__ void attn_item(const Params& p, int l, int item, char* lds, int split, char* lds_all) {
  char* ws = opaque_ptr(p.ws);
  const bf16_t* z = (const bf16_t*)(ws + OFF_Z);
  bf16_t* yda = (bf16_t*)(ws + OFF_YDA);
  int seq, h, qt;
  if (item < 256) { seq = 16 + (item >> 6); h = (item >> 4) & 3; qt = item & 15; }
  else { int i2 = item - 256; seq = i2 >> 4; h = (i2 >> 2) & 3; qt = i2 & 3; }
  const bool lat = seq >= 16;
  const int rowbase = lat ? NCTX + (seq - 16) * 1024 : seq * 256;
  const int nkt_all = lat ? 20 : 4;
  const int vh = p.wave >> 2;
  const int kt0 = split ? vh * (nkt_all >> 1) : 0;
  const int nkt = split ? kt0 + (nkt_all >> 1) : nkt_all;
  const int tid = opaque_tid(), lane = tid & 63, w = tid >> 6, lr = lane & 15, q = lane >> 4;
  const int qrow = rowbase + qt * 64 + w * 16 + lr;
  bf16x8 qf[2][2];
#pragma unroll
  for (int sub = 0; sub < 2; ++sub)
#pragma unroll
    for (int ks = 0; ks < 2; ++ks) qf[sub][ks] = *(const bf16x8*)(z + (size_t)qrow * ZW + ZQ + h * 128 + sub * 64 + ks * 32 + q * 8);
  f32x4 o[2][8];
#pragma unroll
  for (int sub = 0; sub < 2; ++sub)
#pragma unroll
    for (int vt = 0; vt < 8; ++vt) o[sub][vt] = zero4();
  float mrun[2] = {-1e30f, -1e30f}, lrun[2] = {0.f, 0.f};
  const float sc = 0.125f * 1.4426950408889634f;
  const bf16_t* ckb = (const bf16_t*)(ws + OFF_CKB) + (size_t)(((seq - 16) * 4 + l) * 4 + h) * 32768;
  const bf16_t* cvb = (const bf16_t*)(ws + OFF_CVB) + (size_t)(((seq - 16) * 4 + l) * 4 + h) * 32768;
  bf16x8 rk[4], rv[4];
#define ATT_LOAD(kt_)                                                                                                        \
  do {                                                                                                                       \
    const int kt__ = (kt_);                                                                                                  \
    if (lat && kt__ < 4) {                                                                                                   \
      _Pragma("unroll") for (int i = 0; i < 4; ++i) {                                                                        \
        int idx = tid + i * 256;                                                                                             \
        rk[i] = *(const bf16x8*)(ckb + (size_t)(kt__ * 64 + (idx >> 4)) * 128 + (idx & 15) * 8);                             \
        rv[i] = *(const bf16x8*)(cvb + (size_t)(kt__ * 64 + (idx >> 4)) * 128 + (idx & 15) * 8);                             \
      }                                                                                                                      \
    } else {                                                                                                                 \
      const int r0 = lat ? rowbase + (kt__ - 4) * 64 : rowbase + kt__ * 64;                                                  \
      _Pragma("unroll") for (int i = 0; i < 4; ++i) {                                                                        \
        int idx = tid + i * 256;                                                                                             \
        rk[i] = *(const bf16x8*)(z + (size_t)(r0 + (idx >> 4)) * ZW + ZK + h * 128 + (idx & 15) * 8);                        \
        rv[i] = *(const bf16x8*)(z + (size_t)(r0 + (idx >> 4)) * ZW + ZV + h * 128 + (idx & 15) * 8);                        \
      }                                                                                                                      \
    }                                                                                                                        \
  } while (0)
#define ATT_STORE(buf_)                                                                                                      \
  do {                                                                                                                       \
    bf16_t* Ks_ = (bf16_t*)(lds + (buf_) * 34816);                                                                           \
    bf16_t* Vt_ = Ks_ + 64 * 136;                                                                                            \
    _Pragma("unroll") for (int i = 0; i < 4; ++i) {                                                                          \
      int idx = tid + i * 256;                                                                                               \
      *(bf16x8*)(Ks_ + (idx >> 4) * 136 + (idx & 15) * 8) = rk[i];                                                           \
      *(bf16x8*)(Vt_ + (idx >> 4) * 136 + (idx & 15) * 8) = rv[i];              \
    }                                                                                                                        \
  } while (0)
  __syncthreads();
  ATT_LOAD(kt0);
  ATT_STORE(kt0 & 1);
  __syncthreads();
  for (int kt = kt0; kt < nkt; ++kt) {
    if (kt + 1 < nkt) ATT_LOAD(kt + 1);
    const bf16_t* Ks = (const bf16_t*)(lds + (kt & 1) * 34816);
    const bf16_t* Vt = Ks + 64 * 136;
    f32x4 s[2][4];
#pragma unroll
    for (int sub = 0; sub < 2; ++sub)
#pragma unroll
      for (int k16 = 0; k16 < 4; ++k16) {
        f32x4 a = zero4();
#pragma unroll
        for (int ks = 0; ks < 2; ++ks) {
          bf16x8 kf = *(const bf16x8*)(Ks + (k16 * 16 + lr) * 136 + sub * 64 + ks * 32 + q * 8);
          a = MFMA(kf, qf[sub][ks], a);
        }
        s[sub][k16] = a;
      }
#pragma unroll
    for (int sub = 0; sub < 2; ++sub) {
      float mx = -1e30f;
#pragma unroll
      for (int k16 = 0; k16 < 4; ++k16)
#pragma unroll
        for (int r = 0; r < 4; ++r) mx = fmaxf(mx, s[sub][k16][r]);
      mx *= sc;
      mx = fmaxf(mx, __shfl_xor(mx, 16));
      mx = fmaxf(mx, __shfl_xor(mx, 32));
      float mn = fmaxf(mrun[sub], mx);
      float alpha = __builtin_amdgcn_exp2f(mrun[sub] - mn);
      mrun[sub] = mn;
      float ps = 0.f;
#pragma unroll
      for (int k16 = 0; k16 < 4; ++k16)
#pragma unroll
        for (int r = 0; r < 4; ++r) { float pv = __builtin_amdgcn_exp2f(s[sub][k16][r] * sc - mn); s[sub][k16][r] = pv; ps += pv; }
      lrun[sub] = lrun[sub] * alpha + ps;
#pragma unroll
      for (int vt = 0; vt < 8; ++vt) { o[sub][vt][0] *= alpha; o[sub][vt][1] *= alpha; o[sub][vt][2] *= alpha; o[sub][vt][3] *= alpha; }
    }
#pragma unroll
    for (int a = 0; a < 2; ++a) {
      bf16x8 pf0 = pack8(s[0][2 * a], s[0][2 * a + 1]);
      bf16x8 pf1 = pack8(s[1][2 * a], s[1][2 * a + 1]);
#pragma unroll
      for (int vt = 0; vt < 8; ++vt) {
        typedef short s4v __attribute__((ext_vector_type(4)));
        const bf16_t* va0 = Vt + (a * 32 + q * 4 + (lr >> 2)) * 136 + vt * 16 + 4 * (lr & 3);
        bf16x4 v0 = __builtin_amdgcn_ds_read_tr16_b64_v4i16((__attribute__((address_space(3))) s4v*)va0);
        bf16x4 v1 = __builtin_amdgcn_ds_read_tr16_b64_v4i16((__attribute__((address_space(3))) s4v*)(va0 + 16 * 136));
        bf16x8 vf = cat4(v0, v1);
        o[0][vt] = MFMA(vf, pf0, o[0][vt]);
        o[1][vt] = MFMA(vf, pf1, o[1][vt]);
      }
    }
    if (kt + 1 < nkt) ATT_STORE((kt + 1) & 1);
    __syncthreads();
  }
#undef ATT_LOAD
#undef ATT_STORE
  if (split) {
    float* xch = (float*)(lds_all + VLDS);
    if (vh == 1) {
#pragma unroll
      for (int sub = 0; sub < 2; ++sub) {
#pragma unroll
        for (int vt = 0; vt < 8; ++vt)
#pragma unroll
          for (int r = 0; r < 4; ++r) xch[(w * 68 + sub * 32 + vt * 4 + r) * 64 + lane] = o[sub][vt][r];
        xch[(w * 68 + 64 + sub) * 64 + lane] = mrun[sub];
        xch[(w * 68 + 66 + sub) * 64 + lane] = lrun[sub];
      }
    }
    __syncthreads();
    if (vh == 1) return;
#pragma unroll
    for (int sub = 0; sub < 2; ++sub) {
      const float mB = xch[(w * 68 + 64 + sub) * 64 + lane], lB = xch[(w * 68 + 66 + sub) * 64 + lane];
      const float mn = fmaxf(mrun[sub], mB);
      const float aA = __builtin_amdgcn_exp2f(mrun[sub] - mn), aB = __builtin_amdgcn_exp2f(mB - mn);
      lrun[sub] = lrun[sub] * aA + lB * aB;
#pragma unroll
      for (int vt = 0; vt < 8; ++vt)
#pragma unroll
        for (int r = 0; r < 4; ++r) o[sub][vt][r] = o[sub][vt][r] * aA + xch[(w * 68 + sub * 32 + vt * 4 + r) * 64 + lane] * aB;
    }
  }
  float l1 = lrun[0], l2 = lrun[1];
  l1 += __shfl_xor(l1, 16); l1 += __shfl_xor(l1, 32);
  l2 += __shfl_xor(l2, 16); l2 += __shfl_xor(l2, 32);
  float d1 = p.da_lambda[(l * 4 + 0) * 64 + lane] * p.da_lambda[(l * 4 + 1) * 64 + lane];
  float d2 = p.da_lambda[(l * 4 + 2) * 64 + lane] * p.da_lambda[(l * 4 + 3) * 64 + lane];
#pragma unroll
  for (int of = 1; of < 64; of <<= 1) { d1 += __shfl_xor(d1, of); d2 += __shfl_xor(d2, of); }
  int li = l; asm volatile("" : "+v"(li)); const float lf = (float)li;
  const float lam_init = 0.8f - 0.6f * expf(-0.3f * lf);
  const float lam = expf(d1) - expf(d2) + lam_init;
  const float i1 = 1.f / l1, i2 = lam / l2;
  float ss = 0.f;
#pragma unroll
  for (int vt = 0; vt < 8; ++vt)
#pragma unroll
    for (int r = 0; r < 4; ++r) { float v = o[0][vt][r] * i1 - o[1][vt][r] * i2; o[0][vt][r] = v; ss += v * v; }
  ss += __shfl_xor(ss, 16); ss += __shfl_xor(ss, 32);
  const float rstd = rsqrtf(ss * (1.f / 128.f) + 1e-6f) * (1.f - lam_init);
#pragma unroll
  for (int vt = 0; vt < 8; ++vt) {
    f32x4 g = *(const f32x4*)(p.da_norm_g + l * 128 + vt * 16 + q * 4);
    *(bf16x4*)(yda + (size_t)qrow * 512 + h * 128 + vt * 16 + q * 4) =
        pack4(o[0][vt][0] * rstd * g[0], o[0][vt][1] * rstd * g[1], o[0][vt][2] * rstd * g[2], o[0][vt][3] * rstd * g[3]);
  }
}

__device__ __forceinline__ void conv_silu8(const Params& p, int l, const bf16_t* z, int row, bool hp, bool hn, int zcol, int cch, float scale, float (&out)[8]) {
  bf16x8 x1 = *(const bf16x8*)(z + (size_t)row * ZW + zcol);
  bf16x8 x0 = zero8(), x2 = zero8();
  if (hp) x0 = *(const bf16x8*)(z + (size_t)(row - 1) * ZW + zcol);
  if (hn) x2 = *(const bf16x8*)(z + (size_t)(row + 1) * ZW + zcol);
  const float* cw = p.ml_conv_w + (size_t)l * 3 * 1024 + cch;
  const float* cb = p.ml_conv_b + (size_t)l * 1024 + cch;
  float w0[8], w1[8], w2[8], bv[8];
  {
    f32x4 t0 = *(const f32x4*)cw, t1 = *(const f32x4*)(cw + 4), t2 = *(const f32x4*)(cw + 1024), t3 = *(const f32x4*)(cw + 1028);
    f32x4 t4 = *(const f32x4*)(cw + 2048), t5 = *(const f32x4*)(cw + 2052), t6 = *(const f32x4*)cb, t7 = *(const f32x4*)(cb + 4);
#pragma unroll
    for (int e = 0; e < 4; ++e) { w0[e] = t0[e]; w0[4 + e] = t1[e]; w1[e] = t2[e]; w1[4 + e] = t3[e]; w2[e] = t4[e]; w2[4 + e] = t5[e]; bv[e] = t6[e]; bv[4 + e] = t7[e]; }
  }
#pragma unroll
  for (int e = 0; e < 8; ++e) {
    float v = w0[e] * bfs(x0[e]) + w1[e] * bfs(x1[e]) + w2[e] * bfs(x2[e]) + bv[e];
    out[e] = siluf(v) * scale;
  }
}

__device__ __forceinline__ void ml_gate_scan(const float* gp, int row0, int h, int dir, int lane, float* bb, float* cc, float* am, float* gout) {
  const int j0 = 2 * lane, j1 = 2 * lane + 1;
  const int t0 = dir == 0 ? j0 : 127 - j0, t1 = dir == 0 ? j1 : 127 - j1;
  const float ig0 = gp[(size_t)(row0 + t0) * 16 + dir * 4 + h], ig1 = gp[(size_t)(row0 + t1) * 16 + dir * 4 + h];
  const float lf0 = gp[(size_t)(row0 + t0) * 16 + 8 + dir * 4 + h], lf1 = gp[(size_t)(row0 + t1) * 16 + 8 + dir * 4 + h];
  const float pair = lf0 + lf1;
  float x = pair;
#pragma unroll
  for (int off = 1; off < 64; off <<= 1) { float v = __shfl_up(x, off); if (lane >= off) x += v; }
  const float b0 = (x - pair) + lf0, b1 = b0 + lf1;
  const float c0 = ig0 - b0, c1 = ig1 - b1;
  float pm = fmaxf(c0, c1);
#pragma unroll
  for (int off = 1; off < 64; off <<= 1) { float v = __shfl_up(pm, off); if (lane >= off) pm = fmaxf(pm, v); }
  float ex = __shfl_up(pm, 1);
  if (lane == 0) ex = -1e30f;
  const float a0 = fmaxf(ex, c0), a1 = fmaxf(a0, c1);
  bb[t0] = b0; bb[t1] = b1; cc[t0] = c0; cc[t1] = c1; am[t0] = a0; am[t1] = a1;
  gout[t0] = b0; gout[t1] = b1; gout[128 + t0] = c0; gout[128 + t1] = c1; gout[256 + t0] = a0; gout[256 + t1] = a1;
}

__device__ void mlu_item(const Params& p, int l, int item, char* lds) {
  char* ws = opaque_ptr(p.ws);
  const bf16_t* z = (const bf16_t*)(ws + OFF_Z);
  const float* gp = (const float*)(ws + OFF_GP);
  bf16_t* mqc = (bf16_t*)(ws + OFF_MQC);
  bf16_t* mkc = (bf16_t*)(ws + OFF_MKC);
  const int h = item & 3, chunk = item >> 2;
  const int row0 = chunk * 128;
  const int T = row0 < NCTX ? 256 : 1024;
  const int seqbase = row0 < NCTX ? (row0 & ~255) : NCTX + ((row0 - NCTX) & ~1023);
  const int tpos0 = row0 - seqbase;
  const int tid = opaque_tid(), lane = tid & 63, w = tid >> 6, lr = lane & 15, q = lane >> 4;
  bf16_t* KT = (bf16_t*)lds;
  bf16_t* Vt = (bf16_t*)(lds + 34816);
  float* fl = (float*)(lds + 69632);
  __syncthreads();
  if (w < 2) ml_gate_scan(gp, row0, h, w, lane, fl + w * 128, fl + 256 + w * 128, fl + 512 + w * 128, (float*)(ws + OFF_GB) + (size_t)((chunk * 4 + h) * 2 + w) * 384);
#pragma unroll 2
  for (int i = 0; i < 8; ++i) {
    const int idx = tid + i * 256;
    const int s = idx >> 4, dch = idx & 15;
    const int row = row0 + s;
    const bool hp = (tpos0 + s) > 0, hn = (tpos0 + s) < T - 1;
    float kv[8];
    conv_silu8(p, l, z, row, hp, hn, MK + h * 128 + dch * 8, 512 + h * 128 + dch * 8, 0.08838834764831845f, kv);
    bf16x8 vv = *(const bf16x8*)(z + (size_t)row * ZW + MV + h * 128 + dch * 8);
    bf16x8 ko;
#pragma unroll
    for (int e = 0; e < 8; ++e) ko[e] = (short)f2bf(kv[e]);
    *(bf16x8*)(KT + s * 136 + dch * 8) = ko;
    *(bf16x8*)(Vt + s * 136 + dch * 8) = vv;
    *(bf16x8*)(mkc + (size_t)row * 512 + h * 128 + dch * 8) = ko;
    float qv[8];
    conv_silu8(p, l, z, row, hp, hn, MQ + h * 128 + dch * 8, h * 128 + dch * 8, 1.f, qv);
    bf16x8 qo;
#pragma unroll
    for (int e = 0; e < 8; ++e) qo[e] = (short)f2bf(qv[e]);
    *(bf16x8*)(mqc + (size_t)row * 512 + h * 128 + dch * 8) = qo;
  }
  __syncthreads();
  const bf16x8 ones = {0x3F80, 0x3F80, 0x3F80, 0x3F80, 0x3F80, 0x3F80, 0x3F80, 0x3F80};
#pragma unroll 1
  for (int dir = 0; dir < 2; ++dir) {
    const float* bb = fl + dir * 128;
    const float* cc = fl + 256 + dir * 128;
    const float* am = fl + 512 + dir * 128;
    const float B_L = dir == 0 ? bb[127] : bb[0];
    const float amax = dir == 0 ? am[127] : am[0];
    const int uitem = item * 2 + dir;
    float* Uc = (float*)(ws + OFF_UC) + (size_t)uitem * 16384;
    float* Un = (float*)(ws + OFF_UN) + (size_t)uitem * 128;
    float* Usc = (float*)(ws + OFF_USC) + uitem * 2;
    f32x4 acc[2][8], nacc[2];
#pragma unroll
    for (int dt = 0; dt < 2; ++dt) { nacc[dt] = zero4();
#pragma unroll
      for (int vt = 0; vt < 8; ++vt) acc[dt][vt] = zero4(); }
#pragma unroll
    for (int ks = 0; ks < 4; ++ks) {
      f32x4 g0 = *(const f32x4*)(cc + ks * 32 + q * 8), g1 = *(const f32x4*)(cc + ks * 32 + q * 8 + 4);
      float gg[8];
#pragma unroll
      for (int e = 0; e < 4; ++e) { gg[e] = __expf(g0[e] - amax); gg[4 + e] = __expf(g1[e] - amax); }
      bf16x8 af[2];
#pragma unroll
      for (int dt = 0; dt < 2; ++dt) {
        const bf16_t* ka = KT + (ks * 32 + q * 8 + (lr >> 2)) * 136 + w * 32 + dt * 16 + 4 * (lr & 3);
        bf16x8 kf = cat4(lds_tr4(ka), lds_tr4(ka + 4 * 136));
#pragma unroll
        for (int e = 0; e < 8; ++e) af[dt][e] = (short)f2bf(bfs(kf[e]) * gg[e]);
      }
#pragma unroll
      for (int dt = 0; dt < 2; ++dt) nacc[dt] = MFMA(af[dt], ones, nacc[dt]);
#pragma unroll
      for (int vt = 0; vt < 8; ++vt) {
        const bf16_t* va = Vt + (ks * 32 + q * 8 + (lr >> 2)) * 136 + vt * 16 + 4 * (lr & 3);
        bf16x8 bfr = cat4(lds_tr4(va), lds_tr4(va + 4 * 136));
#pragma unroll
        for (int dt = 0; dt < 2; ++dt) acc[dt][vt] = MFMA(af[dt], bfr, acc[dt][vt]);
      }
      __builtin_amdgcn_sched_barrier(0);
    }
#pragma unroll
    for (int dt = 0; dt < 2; ++dt)
#pragma unroll
      for (int r = 0; r < 4; ++r) {
        int d = w * 32 + dt * 16 + q * 4 + r;
#pragma unroll
        for (int vt = 0; vt < 8; ++vt) Uc[d * 128 + vt * 16 + lr] = acc[dt][vt][r];
        if (lr == 0) Un[d] = nacc[dt][r];
      }
    if (tid == 0) { Usc[0] = B_L; Usc[1] = B_L + amax; }
  }
}

template <int NC>
__device__ __forceinline__ void scan_chain(const Params& p, int l, int sl, int seq, int h, int dir, int tid) {
  char* ws = p.ws;
  const float* UcAll = (const float*)(ws + OFF_UC);
  const float* UnAll = (const float*)(ws + OFF_UN);
  const float* UscAll = (const float*)(ws + OFF_USC);
  bf16_t* ctt = (bf16_t*)(ws + OFF_CTT);
  float* nst = (float*)(ws + OFF_NST);
  float* mst = (float*)(ws + OFF_MST);
  constexpr bool lat = NC == 8;
  const int chunk0 = lat ? 32 + (seq - 16) * 8 : seq * 2;
  const int bidx = lat ? seq - 16 : seq;
  const int idx = sl * 256 + tid;
  const int v = idx & 127, d0 = (idx >> 7) * 8;
  const int sidx = ((bidx * 4 + l) * 2 + dir) * 4 + h;
  const bool do_n = (sl == 0) && (tid < 128);
  float u[NC][8], un[NC], Bv[NC], av[NC];
#pragma unroll
  for (int k = 0; k < NC; ++k) {
    const int j = dir == 0 ? k : NC - 1 - k;
    const int it = ((chunk0 + j) * 4 + h) * 2 + dir;
#pragma unroll
    for (int e = 0; e < 8; ++e) u[k][e] = UcAll[(size_t)it * 16384 + (d0 + e) * 128 + v];
    un[k] = do_n ? UnAll[(size_t)it * 128 + tid] : 0.f;
    Bv[k] = UscAll[it * 2]; av[k] = UscAll[it * 2 + 1];
  }
  float C[8];
#pragma unroll
  for (int e = 0; e < 8; ++e) { if (lat) C[e] = p.state_C[(size_t)sidx * 16384 + (d0 + e) * 128 + v]; else { float zz; asm volatile("v_mov_b32 %0, 0" : "=v"(zz)); C[e] = zz; } }
  float nv = (lat && do_n) ? p.state_n[(size_t)sidx * 128 + tid] : 0.f;
  float m = lat ? p.state_m[sidx] : 0.f;
#pragma unroll
  for (int k = 0; k < NC; ++k) {
    const int j = dir == 0 ? k : NC - 1 - k;
    const int it = ((chunk0 + j) * 4 + h) * 2 + dir;
    *(bf16x8*)(ctt + (size_t)it * 16384 + v * 128 + d0) = pack8((f32x4){C[0], C[1], C[2], C[3]}, (f32x4){C[4], C[5], C[6], C[7]});
    if (do_n) nst[(size_t)it * 128 + tid] = nv;
    if (idx == 0) mst[it] = m;
    const float mn = fmaxf(Bv[k] + m, av[k]);
    const float de = __expf(Bv[k] + m - mn), su = __expf(av[k] - mn);
#pragma unroll
    for (int e = 0; e < 8; ++e) C[e] = de * C[e] + su * u[k][e];
    nv = de * nv + su * un[k];
    m = mn;
  }
  if (!lat) {
#pragma unroll
    for (int e = 0; e < 8; ++e) p.out[O_SC + (size_t)sidx * 16384 + (d0 + e) * 128 + v] = C[e];
    if (do_n) p.out[O_SN + (size_t)sidx * 128 + tid] = nv;
    if (idx == 0) p.out[O_SM + sidx] = m;
  }
}
__device__ void scan_item(const Params& p, int l, int item) {
  const int sl = item & 7, c = item >> 3;
  const int dir = c & 1, h = (c >> 1) & 3, seq = c >> 3;
  const int tid = opaque_tid();
  if (seq >= 16) scan_chain<8>(p, l, sl, seq, h, dir, tid); else scan_chain<2>(p, l, sl, seq, h, dir, tid);
}

__device__ void mlh_item(const Params& p, int l, int item, char* lds) {
  char* ws = opaque_ptr(p.ws);
  const bf16_t* z = (const bf16_t*)(ws + OFF_Z);
  bf16_t* yml = (bf16_t*)(ws + OFF_YML);
  const bf16_t* mqc = (const bf16_t*)(ws + OFF_MQC);
  const bf16_t* mkc = (const bf16_t*)(ws + OFF_MKC);
  const int thalf = item & 1, h = (item >> 1) & 3, chunk = item >> 3;
  const int row0 = chunk * 128;
  const int tid = opaque_tid(), lane = tid & 63, w = tid >> 6, lr = lane & 15, q = lane >> 4;
  bf16_t* bufA = (bf16_t*)lds;
  bf16_t* bufB = (bf16_t*)(lds + 34816);
  float* fl = (float*)(lds + 69632);
  __syncthreads();
  {
    const float* gsrc = (const float*)(ws + OFF_GB) + (size_t)((chunk * 4 + h) * 2) * 384;
    for (int i = tid; i < 768; i += 256) {
      int dir = i / 384, r = i % 384;
      fl[(r >> 7) * 256 + dir * 128 + (r & 127)] = gsrc[i];
    }
    const bf16_t* vtt = (const bf16_t*)(ws + OFF_VTT) + (size_t)(chunk * 4 + h) * 16384;
#pragma unroll
    for (int i = 0; i < 8; ++i) {
      int idx = tid + i * 256;
      int s = idx >> 4, ch = idx & 15;
      *(bf16x8*)(bufA + s * 136 + ch * 8) = *(const bf16x8*)(mkc + (size_t)(row0 + s) * 512 + h * 128 + ch * 8);
      *(bf16x8*)(bufB + s * 136 + ch * 8) = *(const bf16x8*)(z + (size_t)(row0 + s) * ZW + MV + h * 128 + ch * 8);
    }
  }
  __syncthreads();
  const int t = thalf * 64 + w * 16 + lr;
  const float* mst = (const float*)(ws + OFF_MST);
  bf16x8 qf[4];
#pragma unroll
  for (int ks = 0; ks < 4; ++ks) qf[ks] = *(const bf16x8*)(mqc + (size_t)(row0 + t) * 512 + h * 128 + ks * 32 + q * 8);
  bf16x8 pf[2][4];
  float dens[2], mtt[2], sint[2];
  {
    f32x4 sa[8];
#pragma unroll
    for (int st = 0; st < 8; ++st) sa[st] = zero4();
#pragma unroll
    for (int ks = 0; ks < 4; ++ks) {
#pragma unroll
      for (int st = 0; st < 8; ++st) {
        bf16x8 kf = *(const bf16x8*)(bufA + (st * 16 + lr) * 136 + ks * 32 + q * 8);
        sa[st] = MFMA(kf, qf[ks], sa[st]);
      }
      __builtin_amdgcn_sched_barrier(0);
    }
#pragma unroll
    for (int dir = 0; dir < 2; ++dir) {
      const float mprev = mst[(chunk * 4 + h) * 2 + dir];
      const float bbt = fl[dir * 128 + t];
      const float mt_ = fmaxf(bbt + mprev, bbt + fl[512 + dir * 128 + t]);
      mtt[dir] = mt_;
      sint[dir] = __expf(bbt + mprev - mt_);
      const float bt = bbt - mt_;
      float dsum = 0.f;
      f32x4 pw[8];
#pragma unroll
      for (int st = 0; st < 8; ++st) {
        f32x4 cs = *(const f32x4*)(fl + 256 + dir * 128 + st * 16 + q * 4);
#pragma unroll
        for (int r = 0; r < 4; ++r) {
          int s = st * 16 + q * 4 + r;
          bool ok = dir == 0 ? (s <= t) : (s >= t);
          float wgt = ok ? __expf(bt + cs[r]) : 0.f;
          float pv = sa[st][r] * wgt;
          pw[st][r] = pv;
          dsum += pv;
        }
      }
      dens[dir] = dsum;
#pragma unroll
      for (int a = 0; a < 4; ++a) pf[dir][a] = pack8(pw[2 * a], pw[2 * a + 1]);
      __builtin_amdgcn_sched_barrier(0);
    }
  }
  f32x4 hsum[8];
  bf16x8 ctr[8];
  {
    const bf16_t* ctt0 = (const bf16_t*)(ws + OFF_CTT) + (size_t)((chunk * 4 + h) * 2) * 16384;
#pragma unroll
    for (int i = 0; i < 8; ++i) { int idx = tid + i * 256; ctr[i] = *(const bf16x8*)(ctt0 + (idx >> 4) * 128 + (idx & 15) * 8); }
  }
#pragma unroll
  for (int dir = 0; dir < 2; ++dir) {
    const int sitem = (chunk * 4 + h) * 2 + dir;
    const float* nvec = (const float*)(ws + OFF_NST) + (size_t)sitem * 128;
    __syncthreads();
#pragma unroll
    for (int i = 0; i < 8; ++i) { int idx = tid + i * 256; *(bf16x8*)(bufA + (idx >> 4) * 136 + (idx & 15) * 8) = ctr[i]; }
    if (dir == 0) {
      const bf16_t* ctt1 = (const bf16_t*)(ws + OFF_CTT) + (size_t)((chunk * 4 + h) * 2 + 1) * 16384;
#pragma unroll
      for (int i = 0; i < 8; ++i) { int idx = tid + i * 256; ctr[i] = *(const bf16x8*)(ctt1 + (idx >> 4) * 128 + (idx & 15) * 8); }
    }
    __syncthreads();
    f32x4 acc[8];
#pragma unroll
    for (int vt = 0; vt < 8; ++vt) acc[vt] = zero4();
    f32x4 qn = zero4();
    bf16x8 nfr[4];
#pragma unroll
    for (int ks = 0; ks < 4; ++ks) nfr[ks] = ld_f32x8_bf(nvec + ks * 32 + q * 8);
#pragma unroll
    for (int ks = 0; ks < 4; ++ks) {
      const bf16x8 nf = nfr[ks];
      qn = MFMA(nf, qf[ks], qn);
#pragma unroll
      for (int vt = 0; vt < 8; ++vt) {
        bf16x8 cf = *(const bf16x8*)(bufA + (vt * 16 + lr) * 136 + ks * 32 + q * 8);
        acc[vt] = MFMA(cf, qf[ks], acc[vt]);
      }
      __builtin_amdgcn_sched_barrier(0);
    }
#pragma unroll
    for (int vt = 0; vt < 8; ++vt) { acc[vt][0] *= sint[dir]; acc[vt][1] *= sint[dir]; acc[vt][2] *= sint[dir]; acc[vt][3] *= sint[dir]; }
#pragma unroll
    for (int a = 0; a < 4; ++a) {
#pragma unroll
      for (int vt = 0; vt < 8; ++vt) {
        const bf16_t* va0 = bufB + (a * 32 + q * 4 + (lr >> 2)) * 136 + vt * 16 + 4 * (lr & 3);
        bf16x4 v0 = lds_tr4(va0);
        bf16x4 v1 = lds_tr4(va0 + 16 * 136);
        acc[vt] = MFMA(cat4(v0, v1), pf[dir][a], acc[vt]);
      }
      __builtin_amdgcn_sched_barrier(0);
    }
    float ds = dens[dir];
    ds += __shfl_xor(ds, 16); ds += __shfl_xor(ds, 32);
    const float den = ds + sint[dir] * qn[0];
    const float inv = 1.f / fmaxf(fabsf(den), __expf(-mtt[dir]));
#pragma unroll
    for (int vt = 0; vt < 8; ++vt) {
      if (dir == 0) hsum[vt] = (f32x4){acc[vt][0] * inv, acc[vt][1] * inv, acc[vt][2] * inv, acc[vt][3] * inv};
      else { hsum[vt][0] += acc[vt][0] * inv; hsum[vt][1] += acc[vt][1] * inv; hsum[vt][2] += acc[vt][2] * inv; hsum[vt][3] += acc[vt][3] * inv; }
    }
  }
  {
    float ss = 0.f;
#pragma unroll
    for (int vt = 0; vt < 8; ++vt)
#pragma unroll
      for (int r = 0; r < 4; ++r) ss += hsum[vt][r] * hsum[vt][r];
    ss += __shfl_xor(ss, 16); ss += __shfl_xor(ss, 32);
    const float rstd = rsqrtf(ss * (1.f / 128.f) + 1e-6f);
#pragma unroll
    for (int vt = 0; vt < 8; ++vt) {
      int v = vt * 16 + q * 4;
      f32x4 g = *(const f32x4*)(p.ml_norm_g + l * 128 + v);
      bf16x4 og = *(const bf16x4*)(z + (size_t)(row0 + t) * ZW + MO + h * 128 + v);
      *(bf16x4*)(yml + (size_t)(row0 + t) * 512 + h * 128 + v) =
          pack4(bfs(og[0]) * hsum[vt][0] * rstd * g[0], bfs(og[1]) * hsum[vt][1] * rstd * g[1],
                bfs(og[2]) * hsum[vt][2] * rstd * g[2], bfs(og[3]) * hsum[vt][3] * rstd * g[3]);
    }
  }
}

__device__ void sg_item(const Params& p, int l, int item, char* lds) {
  char* ws = opaque_ptr(p.ws);
  const bf16_t* z = (const bf16_t*)(ws + OFF_Z);
  bf16_t* ysg = (bf16_t*)(ws + OFF_YSG);
  const int g = item & 3, chunk = item >> 2;
  const int row0 = chunk * 128;
  const int tid = opaque_tid(), lane = tid & 63, w = tid >> 6, lr = lane & 15, q = lane >> 4;
  bf16_t* svT = (bf16_t*)lds;
  float* mean = (float*)(lds + 34816);
  float* rstd = mean + 128;
  __syncthreads();
#pragma unroll 1
  for (int i0 = 0; i0 < 32; i0 += 8) {
    bf16x8 xr[8];
#pragma unroll
    for (int k = 0; k < 8; ++k) xr[k] = *(const bf16x8*)(z + (size_t)(row0 + w * 32 + i0 + k) * ZW + SV + lane * 8);
#pragma unroll
    for (int k = 0; k < 8; ++k) {
      const int t = w * 32 + i0 + k;
      const bf16x8 xv = xr[k];
      float s = 0.f;
#pragma unroll
      for (int e = 0; e < 8; ++e) s += bfs(xv[e]);
#pragma unroll
      for (int of = 1; of < 64; of <<= 1) s += __shfl_xor(s, of);
      float mu = s * (1.f / 512.f);
      float v2 = 0.f;
#pragma unroll
      for (int e = 0; e < 8; ++e) { float d = bfs(xv[e]) - mu; v2 += d * d; }
#pragma unroll
      for (int of = 1; of < 64; of <<= 1) v2 += __shfl_xor(v2, of);
      if (lane == 0) { mean[t] = mu; rstd[t] = rsqrtf(v2 * (1.f / 512.f) + 1e-6f); }
    }
  }
  __syncthreads();
#pragma unroll 2
  for (int i = 0; i < 8; ++i) {
    const int idx = tid + i * 256;
    const int s = idx >> 4, cch = idx & 15;
    const float mu = mean[s], rs = rstd[s];
    bf16x8 xv = *(const bf16x8*)(z + (size_t)(row0 + s) * ZW + SV + g * 128 + cch * 8);
    const float* gn = p.sg_norm_g + l * 512 + g * 128 + cch * 8;
    float nv[8];
#pragma unroll
    for (int e = 0; e < 8; ++e) nv[e] = (bfs(xv[e]) - mu) * rs * gn[e];
    *(bf16x8*)(svT + s * 136 + cch * 8) = pack8((f32x4){nv[0], nv[1], nv[2], nv[3]}, (f32x4){nv[4], nv[5], nv[6], nv[7]});
  }
  __syncthreads();
  f32x4 acc[8][2];
#pragma unroll
  for (int ct = 0; ct < 8; ++ct)
#pragma unroll
    for (int pt = 0; pt < 2; ++pt) acc[ct][pt] = zero4();
#pragma unroll
  for (int ks = 0; ks < 4; ++ks) {
    bf16x8 wf[2];
#pragma unroll
    for (int pt = 0; pt < 2; ++pt) { int rowi = w * 32 + pt * 16 + lr; asm volatile("" : "+v"(rowi)); wf[pt] = ld_f32x8_bf(p.sg_w + ((size_t)(l * 4 + g) * 128 + rowi) * 128 + ks * 32 + q * 8); }
#pragma unroll
    for (int ct = 0; ct < 8; ++ct) {
      const bf16_t* sa_ = svT + (ks * 32 + q * 8 + (lr >> 2)) * 136 + ct * 16 + 4 * (lr & 3);
      bf16x8 sf = cat4(lds_tr4(sa_), lds_tr4(sa_ + 4 * 136));
#pragma unroll
      for (int pt = 0; pt < 2; ++pt) acc[ct][pt] = MFMA(sf, wf[pt], acc[ct][pt]);
    }
    __builtin_amdgcn_sched_barrier(0);
  }
#pragma unroll
  for (int pt = 0; pt < 2; ++pt) {
    int pp = w * 32 + pt * 16 + lr;
    float bias = p.sg_b[(l * 4 + g) * 128 + pp];
#pragma unroll
    for (int ct = 0; ct < 8; ++ct) {
      int c = g * 128 + ct * 16 + q * 4;
      bf16x4 u = *(const bf16x4*)(z + (size_t)(row0 + pp) * ZW + SU + c);
      *(bf16x4*)(ysg + (size_t)(row0 + pp) * 512 + c) =
          pack4(bfs(u[0]) * (acc[ct][pt][0] + bias), bfs(u[1]) * (acc[ct][pt][1] + bias), bfs(u[2]) * (acc[ct][pt][2] + bias), bfs(u[3]) * (acc[ct][pt][3] + bias));
    }
  }
}

__device__ void phase_merge(const Params& p, int l, char* lds) {
  char* ws = opaque_ptr(p.ws);
  const bf16_t* z = (const bf16_t*)(ws + OFF_Z);
  bf16_t* mrg = (bf16_t*)(ws + OFF_MRG);
  const int tid = opaque_tid(), lane = tid & 63, w = tid >> 6, wm = w >> 1, wn = w & 1, lr = lane & 15, q = lane >> 4;
  for (int it = VBLK; it < 64 * 8; it += VGRID) {
    const int nt = it >> 6, mt = it & 63;
    const int m0 = mt * 128, n0 = nt * 128;
    f32x4 macc[4][4];
    zero_acc(macc);
#pragma unroll 1
    for (int br = 0; br < 3; ++br) {
      f32x4 acc[4][4];
      zero_acc(acc);
      const bf16_t* A = (const bf16_t*)(ws + OFF_YDA) + (size_t)br * NTOK * 512;
      const bf16_t* Bt = (const bf16_t*)(ws + OFF_WBR) + (size_t)(l * 3 + br) * 1024 * 512;
      gemm_mainloop(p, acc, A, 512, Bt, 512, m0, n0, 512, lds);
#pragma unroll
      for (int mi = 0; mi < 4; ++mi) {
        int m = m0 + wm * 64 + mi * 16 + lr;
        const bf16_t* gp_ = z + (size_t)m * ZW + GT + br * 1024 + n0 + wn * 64 + q * 4;
#pragma unroll
        for (int ni = 0; ni < 4; ++ni) {
          bf16x4 g = *(const bf16x4*)(gp_ + ni * 16);
          macc[mi][ni][0] += bfs(g[0]) * acc[mi][ni][0]; macc[mi][ni][1] += bfs(g[1]) * acc[mi][ni][1];
          macc[mi][ni][2] += bfs(g[2]) * acc[mi][ni][2]; macc[mi][ni][3] += bfs(g[3]) * acc[mi][ni][3];
        }
      }
    }
#pragma unroll
    for (int mi = 0; mi < 4; ++mi) {
      int m = m0 + wm * 64 + mi * 16 + lr;
      bf16_t* rowp = mrg + (size_t)m * 1024 + n0 + wn * 64 + q * 4;
#pragma unroll
      for (int ni = 0; ni < 4; ++ni) *(bf16x4*)(rowp + ni * 16) = pack4(macc[mi][ni][0], macc[mi][ni][1], macc[mi][ni][2], macc[mi][ni][3]);
    }
  }
}

__device__ void phase_resid(const Params& p, int l, int second, char* lds) {
  char* ws = opaque_ptr(p.ws);
  const bf16_t* A = (const bf16_t*)(ws + (second ? OFF_ACT : OFF_MRG));
  const int K = second ? DFF : 1024;
  const bf16_t* Bt = second ? (const bf16_t*)(ws + OFF_WDN) + (size_t)l * 1024 * DFF : (const bf16_t*)(ws + OFF_WOUT) + (size_t)l * 1024 * 1024;
  const int gate_off = second ? 5120 : 2048;
  const bool has_next = !(second && l == 3);
  bf16_t* anext = (bf16_t*)(ws + (second ? OFF_A1 : OFF_H));
  const int sc_layer = second ? (l < 3 ? l + 1 : l) : l;
  const int sc_off = second ? 1024 : 4096;
  float* x = (float*)(ws + OFF_X);
  float* ssp = (float*)(ws + OFF_SSP);
  const float* mod = (const float*)(ws + OFF_MOD);
  const int tid = opaque_tid(), lane = tid & 63, w = tid >> 6, wm = w >> 1, wn = w & 1, lr = lane & 15, q = lane >> 4;
  for (int it = VBLK; it < 64 * 8; it += VGRID) {
    const int nt = it >> 6, mt = it & 63;
    const int m0 = mt * 128, n0 = nt * 128;
    f32x4 acc[4][4];
    zero_acc(acc);
    gemm_mainloop(p, acc, A, K, Bt, K, m0, n0, K, lds);
    const int cnd = cond_of(m0);
    const float* grow = mod + (size_t)(l * 5 + cnd) * 6144 + gate_off + n0 + wn * 64 + q * 4;
    const float* scrow = mod + (size_t)(sc_layer * 5 + cnd) * 6144 + sc_off + n0 + wn * 64 + q * 4;
    float* ssl = (float*)lds;
    char* stg = lds + 1024 + w * 8192;
    float ssk[4];
#pragma unroll
    for (int mi = 0; mi < 4; ++mi) {
      int m = m0 + wm * 64 + mi * 16 + lr;
      float* rowp = x + (size_t)m * 1024 + n0 + wn * 64 + q * 4;
      float ss = 0.f;
#pragma unroll
      for (int ni = 0; ni < 4; ++ni) {
        f32x4 g = *(const f32x4*)(grow + ni * 16);
        f32x4 xv = *(const f32x4*)(rowp + ni * 16);
        xv[0] += g[0] * acc[mi][ni][0]; xv[1] += g[1] * acc[mi][ni][1]; xv[2] += g[2] * acc[mi][ni][2]; xv[3] += g[3] * acc[mi][ni][3];
        *(f32x4*)(rowp + ni * 16) = xv;
        ss += xv[0] * xv[0] + xv[1] * xv[1] + xv[2] * xv[2] + xv[3] * xv[3];
        if (has_next) {
          f32x4 sc = *(const f32x4*)(scrow + ni * 16);
          *(bf16x4*)(stg + (mi * 16 + lr) * 128 + ((((ni << 1) | (q >> 1)) ^ (lr & 7)) << 4) + ((q & 1) << 3)) = pack4(xv[0] * (1.f + sc[0]), xv[1] * (1.f + sc[1]), xv[2] * (1.f + sc[2]), xv[3] * (1.f + sc[3]));
        }
      }
      ss += __shfl_xor(ss, 16); ss += __shfl_xor(ss, 32);
      if (q == 0 && wn == 1) ssl[wm * 64 + mi * 16 + lr] = ss;
      ssk[mi] = ss;
    }
    if (has_next) {
#pragma unroll
      for (int i = 0; i < 8; ++i) {
        const int r = i * 8 + (lane >> 3), c = lane & 7;
        bf16x8 v = *(const bf16x8*)(stg + r * 128 + ((c ^ (r & 7)) << 4));
        *(bf16x8*)(anext + (size_t)(m0 + wm * 64 + r) * 1024 + n0 + wn * 64 + c * 8) = v;
      }
    }
    __syncthreads();
    if (wn == 0 && q == 0) {
#pragma unroll
      for (int mi = 0; mi < 4; ++mi) ssp[(size_t)nt * NTOK + m0 + wm * 64 + mi * 16 + lr] = ssk[mi] + ssl[wm * 64 + mi * 16 + lr];
    }
    __syncthreads();
  }
}

__device__ void phase_up(const Params& p, int l, char* lds_all) {
  char* ws = opaque_ptr(p.ws);
  const bf16_t* H = (const bf16_t*)(ws + OFF_H);
  const bf16_t* Wt = (const bf16_t*)(ws + OFF_WUP) + (size_t)l * UW * 1024;
  bf16_t* u = (bf16_t*)(ws + OFF_U);
  int tid = real_tid_(p.wave);
  const int lane = tid & 63, w = tid >> 6, wm = w >> 2, wn = w & 3, lr = lane & 15, q = lane >> 4;
  float* rs_lds = (float*)(lds_all + 131072);
  float* sh_lds = (float*)(lds_all + 131072 + 1024);
  int par = 0, cur_mt = -1;
  for (int it = blockIdx.x; it < 32 * 22; it += gridDim.x, par ^= 1) {
    const int ntw = it >> 5, mt = it & 31;
    const int m0 = mt * 256, n0 = ntw * 256;
    if (mt != cur_mt) {
      __syncthreads();
      if (tid < 256) rs_lds[tid] = row_rstd((const float*)(ws + OFF_SSP), m0 + tid);
      cur_mt = mt;
    }
    if (tid < 64) *(f32x4*)(sh_lds + par * 256 + tid * 4) = *(const f32x4*)((const float*)(ws + OFF_SHW2) + (size_t)(l * 5 + cond_of(m0)) * UW + n0 + tid * 4);
    f32x4 acc[8][4];
#pragma unroll
    for (int i = 0; i < 8; ++i)
#pragma unroll
      for (int j = 0; j < 4; ++j) acc[i][j] = zero4();
    gemm_mainloop_8w(acc, H, 1024, Wt, 1024, m0, n0, 1024, lds_all, p.wave);
    int lro = lr; asm volatile("" : "+v"(lro));
    const float* shl = sh_lds + par * 256 + wn * 64 + q * 4;
    char* stg = lds_all + w * 8192;
#pragma unroll
    for (int mh = 0; mh < 2; ++mh) {
#pragma unroll
      for (int mq = 0; mq < 4; ++mq) {
        const int mi = mh * 4 + mq;
        const float rs = rs_lds[wm * 128 + mi * 16 + lro];
#pragma unroll
        for (int ni = 0; ni < 4; ++ni) {
          f32x4 sv = *(const f32x4*)(shl + ni * 16);
          *(bf16x4*)(stg + (mq * 16 + lro) * 128 + ((((ni << 1) | (q >> 1)) ^ (lro & 7)) << 4) + ((q & 1) << 3)) =
              pack4(acc[mi][ni][0] * rs + sv[0], acc[mi][ni][1] * rs + sv[1], acc[mi][ni][2] * rs + sv[2], acc[mi][ni][3] * rs + sv[3]);
        }
      }
#pragma unroll
      for (int i = 0; i < 8; ++i) {
        const int r = i * 8 + (lane >> 3), c = lane & 7;
        bf16x8 v = *(const bf16x8*)(stg + r * 128 + ((c ^ (r & 7)) << 4));
        *(bf16x8*)(u + (size_t)(m0 + wm * 128 + mh * 64 + r) * UW + n0 + wn * 64 + c * 8) = v;
      }
    }
    __syncthreads();
  }
}

__device__ void phase_act(const Params& p, int l) {
  char* ws = opaque_ptr(p.ws);
  const bf16_t* u = (const bf16_t*)(ws + OFF_U);
  bf16_t* act = (bf16_t*)(ws + OFF_ACT);
  const float* cw = p.ffn_conv_w + (size_t)l * 3 * UW;
  const float* cb = p.ffn_conv_b + (size_t)l * UW;
  const int tid = opaque_tid();
  constexpr int RPT = 8;
  const int total = (NTOK / RPT) * 352;
  for (int idx = VBLK * 256 + tid; idx < total; idx += VGRID * 256) {
    const int rg = idx / 352, kc = idx - rg * 352;
    const int mbase = rg * RPT;
    const int T = mbase < NCTX ? 256 : 1024;
    const int tp0 = mbase < NCTX ? (mbase & 255) : ((mbase - NCTX) & 1023);
    const int ca = kc * 8, cbb = DFF + kc * 8;
    float wa[3][8], wb[3][8], ba[8], bb[8];
#pragma unroll
    for (int t = 0; t < 3; ++t) {
      f32x4 x0 = *(const f32x4*)(cw + t * UW + ca), x1 = *(const f32x4*)(cw + t * UW + ca + 4);
      f32x4 y0 = *(const f32x4*)(cw + t * UW + cbb), y1 = *(const f32x4*)(cw + t * UW + cbb + 4);
#pragma unroll
      for (int e = 0; e < 4; ++e) { wa[t][e] = x0[e]; wa[t][4 + e] = x1[e]; wb[t][e] = y0[e]; wb[t][4 + e] = y1[e]; }
    }
    {
      f32x4 x0 = *(const f32x4*)(cb + ca), x1 = *(const f32x4*)(cb + ca + 4), y0 = *(const f32x4*)(cb + cbb), y1 = *(const f32x4*)(cb + cbb + 4);
#pragma unroll
      for (int e = 0; e < 4; ++e) { ba[e] = x0[e]; ba[4 + e] = x1[e]; bb[e] = y0[e]; bb[4 + e] = y1[e]; }
    }
    const bf16_t* up = u + (size_t)mbase * UW + kc * 8;
    bf16x8 a0 = zero8(), b0 = zero8();
    if (tp0 > 0) { a0 = *(const bf16x8*)(up - UW); b0 = *(const bf16x8*)(up - UW + DFF); }
    bf16x8 a1 = *(const bf16x8*)up, b1 = *(const bf16x8*)(up + DFF);
#pragma unroll
    for (int r = 0; r < RPT; ++r) {
      bf16x8 a2 = zero8(), b2 = zero8();
      if (tp0 + r < T - 1) { a2 = *(const bf16x8*)(up + (size_t)(r + 1) * UW); b2 = *(const bf16x8*)(up + (size_t)(r + 1) * UW + DFF); }
      float ov[8];
#pragma unroll
      for (int e = 0; e < 8; ++e) {
        float c1 = wa[0][e] * bfs(a0[e]) + wa[1][e] * bfs(a1[e]) + wa[2][e] * bfs(a2[e]) + ba[e];
        float c2 = wb[0][e] * bfs(b0[e]) + wb[1][e] * bfs(b1[e]) + wb[2][e] * bfs(b2[e]) + bb[e];
        ov[e] = siluf(c1) * c2;
      }
      *(bf16x8*)(act + (size_t)(mbase + r) * DFF + kc * 8) = pack8((f32x4){ov[0], ov[1], ov[2], ov[3]}, (f32x4){ov[4], ov[5], ov[6], ov[7]});
      a0 = a1; a1 = a2; b0 = b1; b1 = b2;
    }
  }
}

__global__ void __launch_bounds__(512, 2) trunk_megakernel(Params p_in) {
  Params p = p_in;
  p.wave = __builtin_amdgcn_readfirstlane((int)(threadIdx.x >> 6));
  extern __shared__ __attribute__((aligned(16))) char lds_all[];
  char* lds = lds_all + VHALF * VLDS;
  cg::grid_group grid = cg::this_grid();
  char* ws = p.ws;
  if (p.never) grid.sync();
  volatile LAS unsigned* xst = (volatile LAS unsigned*)(lds_all + LDS_BYTES - 16);
  if (threadIdx.x == 0) { xst[0] = 0u; xst[1] = 0u; xst[2] = 0u; xst[3] = 0u; }
  __syncthreads();
  XcdBarrier xb = xcd_barrier_post((unsigned*)(ws + OFF_BAR), xst);
  for (int ph = p.phase_begin; ph < p.phase_end; ++ph) {
    if (ph > p.phase_begin) { xcd_barrier(xb);
#ifdef SYNC_REP
      xcd_barrier(xb); xcd_barrier(xb);
#endif
    }
    if (ph == 0) { phase_prologue(p, lds); continue; }
    if (ph == 1) { phase_init(p); continue; }
    if (ph == 38) { phase_norm(p, 0, 2, false); continue; }
    const int l = (ph - 2) / 9, sp = (ph - 2) % 9;
    const int G = VGRID;
    for (int rep = 0; rep < (((p.rep_mask >> sp) & 1) ? 2 : 1); ++rep) {
    if (rep) xcd_barrier(xb);
    switch (sp) {
      case 0: phase_inproj(p, l, lds_all); break;
      case 1: case 2: {
        const int G1 = G >> 1, G2 = G - G1;
        if (sp == 1) {
          if (VBLK < G1) { for (int it = VBLK; it < 256; it += G1) { mlu_item(p, l, it, lds); __syncthreads(); } }
          else for (int it = VBLK - G1; it < 256; it += G2) { sg_item(p, l, it, lds); __syncthreads(); }
        }
        int it0, itN, step, split;
        if (sp == 1) { it0 = (VBLK >= G1) ? 256 + (VBLK - G1) : 512; itN = 512; step = G2; split = 0; }
        else { it0 = blockIdx.x; itN = 256; step = gridDim.x; split = 1; }
        for (int it = it0; it < itN; it += step) { attn_item(p, l, it, lds, split, lds_all); __syncthreads(); }
        if (sp == 2) for (int it = VBLK; it < 1280; it += G) scan_item(p, l, it);
      } break;
      case 3:
        for (int it = VBLK; it < 512; it += G) { mlh_item(p, l, it, lds); __syncthreads(); }
        break;
      case 4: phase_merge(p, l, lds); break;
      case 5: case 8: phase_resid(p, l, sp == 8, lds); break;
      case 6: phase_up(p, l, lds_all); break;
      case 7: phase_act(p, l); break;
    }
    }
  }
}

extern "C" void kernel_launch(void* const* d_in, const int* in_sizes, int n_in, void* d_out, int out_size, void* d_ws, size_t ws_size,
                              hipStream_t stream) {
  static int grid_blocks = 0;
  if (!grid_blocks) {
    int dev = 0, cus = 0, per_cu = 0;
    hipGetDevice(&dev);
    hipDeviceGetAttribute(&cus, hipDeviceAttributeMultiprocessorCount, dev);
    hipFuncSetAttribute((const void*)trunk_megakernel, hipFuncAttributeMaxDynamicSharedMemorySize, LDS_BYTES);
    hipOccupancyMaxActiveBlocksPerMultiprocessor(&per_cu, trunk_megakernel, 512, LDS_BYTES);
    per_cu = 1;
    grid_blocks = cus * per_cu;
  }
  if (ws_size < WS_NEED) { fprintf(stderr, "workspace too small: %zu < %zu\n", ws_size, (size_t)WS_NEED); return; }
  Params p{};
  const float** f = (const float**)&p;
  for (int i = 0; i < 28; ++i) f[i] = (const float*)d_in[i];
  p.out = (float*)d_out;
  p.ws = (char*)d_ws;
  p.phase_begin = 0;
  p.phase_end = 39;
  p.rep_mask = REP_MASK;
  hipMemsetAsync((char*)d_ws + OFF_BAR, 0, 16384, stream);
  void* args[] = {&p};
  hipError_t e = hipLaunchCooperativeKernel((const void*)trunk_megakernel, dim3(grid_blocks), dim3(512), args, LDS_BYTES, stream);
  if (e != hipSuccess) fprintf(stderr, "cooperative launch failed: %s (grid %d)\n", hipGetErrorString(e), grid_blocks);
}
```

```cpp
#include <hip/hip_runtime.h>
#include <hip/hip_cooperative_groups.h>
#include <cstdio>
#include <cstdint>
namespace cg = cooperative_groups;

typedef unsigned short bf16_t;
typedef short bf16x8 __attribute__((ext_vector_type(8)));
typedef short bf16x4 __attribute__((ext_vector_type(4)));
typedef float f32x4 __attribute__((ext_vector_type(4)));
typedef unsigned u32x2 __attribute__((ext_vector_type(2)));
typedef float f32x2 __attribute__((ext_vector_type(2)));

constexpr int DM = 1024, NTOK = 8192, NCTX = 4096, NL = 4;
constexpr int NIN = 7696, NINP = 7936, ZW = 7680;
constexpr int DFF = 2816, UW = 5632;
constexpr int ZQ = 0, ZK = 512, ZV = 1024, MQ = 1536, MK = 2048, MV = 2560, MO = 3072, SU = 3584, SV = 4096, GT = 4608;
constexpr int VLDS = 77824;
constexpr int LDS_BYTES = 2 * VLDS + 16;
#define VHALF (p.wave >> 2)
#define VBLK ((int)(blockIdx.x * 2) + VHALF)
#define VGRID ((int)(gridDim.x * 2))
#ifndef REP_MASK
#define REP_MASK 0
#endif

constexpr size_t SZ_WIN = (size_t)NL * NINP * 1024 * 2;
constexpr size_t SZ_WBR = (size_t)NL * 3 * 1024 * 512 * 2;
constexpr size_t SZ_WOUT = (size_t)NL * 1024 * 1024 * 2;
constexpr size_t SZ_WUP = (size_t)NL * UW * 1024 * 2;
constexpr size_t SZ_WDN = (size_t)NL * 1024 * DFF * 2;
constexpr size_t OFF_WIN = 0;
constexpr size_t OFF_WBR = OFF_WIN + SZ_WIN;
constexpr size_t OFF_WOUT = OFF_WBR + SZ_WBR;
constexpr size_t OFF_WUP = OFF_WOUT + SZ_WOUT;
constexpr size_t OFF_WDN = OFF_WUP + SZ_WUP;
constexpr size_t OFF_X = OFF_WDN + SZ_WDN;
constexpr size_t OFF_H = OFF_X + (size_t)NTOK * 1024 * 4;
constexpr size_t OFF_MRG = OFF_H + (size_t)NTOK * 1024 * 2;
constexpr size_t OFF_YDA = OFF_MRG + (size_t)NTOK * 1024 * 2;
constexpr size_t OFF_YML = OFF_YDA + (size_t)NTOK * 512 * 2;
constexpr size_t OFF_YSG = OFF_YML + (size_t)NTOK * 512 * 2;
constexpr size_t OFF_ACT = OFF_H;
constexpr size_t OFF_Z = OFF_YSG + (size_t)NTOK * 512 * 2;
constexpr size_t OFF_U = OFF_Z;
constexpr size_t OFF_GP = OFF_Z + (size_t)NTOK * ZW * 2;
constexpr size_t OFF_UC = OFF_GP + (size_t)NTOK * 16 * 4;
constexpr size_t OFF_UN = OFF_UC + (size_t)512 * 16384 * 4;
constexpr size_t OFF_USC = OFF_UN + (size_t)512 * 128 * 4;
constexpr size_t OFF_A1 = OFF_USC + 4096;
constexpr size_t OFF_MOD = OFF_A1 + (size_t)NTOK * 1024 * 2;
constexpr size_t OFF_ROPE = OFF_MOD + (size_t)NL * 5 * 6144 * 4;
constexpr size_t OFF_MQC = OFF_ROPE + 8192;
constexpr size_t OFF_MKC = OFF_MQC + (size_t)NTOK * 512 * 2;
constexpr size_t OFF_CTT = OFF_MKC + (size_t)NTOK * 512 * 2;
constexpr size_t OFF_NST = OFF_CTT + (size_t)512 * 16384 * 2;
constexpr size_t OFF_MST = OFF_NST + (size_t)512 * 128 * 4;
constexpr size_t OFF_GB = OFF_MST + 4096;
constexpr size_t OFF_VTT = OFF_GB + (size_t)512 * 384 * 4;
constexpr size_t OFF_SSP = OFF_VTT + (size_t)256 * 16384 * 2;
constexpr size_t OFF_SHW1 = OFF_SSP + (size_t)16 * NTOK * 4;
constexpr size_t OFF_SHW2 = OFF_SHW1 + (size_t)NL * 5 * NINP * 4;
constexpr size_t OFF_CKB = OFF_SHW2 + (size_t)NL * 5 * UW * 4;
constexpr size_t OFF_CVB = OFF_CKB + (size_t)2097152 * 2;
constexpr size_t OFF_BAR = OFF_CVB + (size_t)2097152 * 2;
constexpr size_t WS_NEED = OFF_BAR + 16384;

constexpr int O_YP = 0, O_YS = 4194304, O_CK = 8388608, O_CV = 16777216, O_SC = 25165824, O_SN = 33554432, O_SM = 33619968;

struct Params {
  const float *x_prompt, *x_sample, *c, *cache_k, *cache_v, *state_C, *state_n, *state_m, *c_ctx, *w_mod, *b_mod, *w_in,
      *da_lambda, *da_norm_g, *ml_conv_w, *ml_conv_b, *ml_gate_b, *ml_norm_g, *sg_norm_g, *sg_w, *sg_b, *w_branch, *w_out,
      *w_up, *ffn_conv_w, *ffn_conv_b, *w_down, *final_g;
  float* out;
  char* ws;
  int phase_begin, phase_end;
  int rep_mask, never;
  int wave, pad2;
};

__device__ __forceinline__ bf16_t f2bf(float f) { __bf16 b = (__bf16)f; return __builtin_bit_cast(bf16_t, b); }
__device__ __forceinline__ float bf2f(bf16_t h) { return __uint_as_float(((unsigned)h) << 16); }
__device__ __forceinline__ float bfs(short h) { return __uint_as_float(((unsigned)(unsigned short)h) << 16); }
__device__ __forceinline__ float siluf(float x) { return x * __builtin_amdgcn_rcpf(1.f + __builtin_amdgcn_exp2f(-1.4426950408889634f * x)); }
__device__ __forceinline__ float sigmf(float x) { return __builtin_amdgcn_rcpf(1.f + __builtin_amdgcn_exp2f(-1.4426950408889634f * x)); }
__device__ __forceinline__ float geluf(float x) { float u = 0.7978845608f * (x + 0.044715f * x * x * x); float t = 1.f - 2.f * __builtin_amdgcn_rcpf(1.f + __builtin_amdgcn_exp2f(2.8853900817779268f * u)); return 0.5f * x * (1.f + t); }
__device__ __forceinline__ float logsigf(float x) { return fminf(x, 0.f) - log1pf(__expf(-fabsf(x))); }
typedef __bf16 bf16x2n __attribute__((ext_vector_type(2)));
__device__ __forceinline__ unsigned cvtpk(float lo, float hi) { f32x2 v = {lo, hi}; bf16x2n b = __builtin_convertvector(v, bf16x2n); return __builtin_bit_cast(unsigned, b); }
__device__ __forceinline__ bf16x4 pack4(float a, float b, float c, float d) { u32x2 r; r[0] = cvtpk(a, b); r[1] = cvtpk(c, d); return __builtin_bit_cast(bf16x4, r); }
typedef unsigned u32x4 __attribute__((ext_vector_type(4)));
__device__ __forceinline__ bf16x8 pack8(f32x4 a, f32x4 b) { u32x4 r; r[0] = cvtpk(a[0], a[1]); r[1] = cvtpk(a[2], a[3]); r[2] = cvtpk(b[0], b[1]); r[3] = cvtpk(b[2], b[3]); return __builtin_bit_cast(bf16x8, r); }
__device__ __forceinline__ bf16x8 cat4(bf16x4 a, bf16x4 b) { bf16x8 r; r[0] = a[0]; r[1] = a[1]; r[2] = a[2]; r[3] = a[3]; r[4] = b[0]; r[5] = b[1]; r[6] = b[2]; r[7] = b[3]; return r; }
__device__ __forceinline__ bf16x8 ld_f32x8_bf(const float* p) { f32x4 a = *(const f32x4*)p, b = *(const f32x4*)(p + 4); return pack8(a, b); }
typedef short s4v_t __attribute__((ext_vector_type(4)));
__device__ __forceinline__ bf16x4 lds_tr4(const bf16_t* p) { return __builtin_amdgcn_ds_read_tr16_b64_v4i16((__attribute__((address_space(3))) s4v_t*)p); }
#define MFMA(a, b, c) __builtin_amdgcn_mfma_f32_16x16x32_bf16((a), (b), (c), 0, 0, 0)
__device__ __forceinline__ int lane_id() { return (int)__builtin_amdgcn_mbcnt_hi(~0u, __builtin_amdgcn_mbcnt_lo(~0u, 0u)); }
#define opaque_tid() opaque_tid_(p.wave)
__device__ __forceinline__ int opaque_tid_(int wave) { int t = ((wave & 3) << 6) | lane_id(); asm volatile("" : "+v"(t)); return t; }
__device__ __forceinline__ int real_tid_(int wave) { int t = (wave << 6) | lane_id(); asm volatile("" : "+v"(t)); return t; }
__device__ __forceinline__ char* opaque_ptr(char* p) { asm volatile("" : "+s"(p)); return p; }
__device__ __forceinline__ f32x4 zero4() { float z; asm volatile("v_mov_b32 %0, 0" : "=v"(z)); f32x4 r = {z, z, z, z}; return r; }
__device__ __forceinline__ bf16x8 zero8() { f32x4 z = zero4(); return __builtin_bit_cast(bf16x8, z); }
__device__ __forceinline__ int cond_of(int row) { return row < NCTX ? 0 : 1 + ((row - NCTX) >> 10); }


#define XB_TMO      128
#define XB_XCNT(j)  (256  + 64 * (j))
#define XB_XSUB(j)  (1280 + 64 * (j))
#define XB_XGEN(j)  (2304 + 64 * (j))
#define XB_TOP      3328
#define XB_TOPGEN   3392
#define XCD_BAR_WORDS 3456
#define XB_SPIN_CAP (1u << 20)
#define LAS __attribute__((address_space(3)))
__device__ __forceinline__ unsigned xb_ld(unsigned* p)              { return __hip_atomic_load(p, __ATOMIC_RELAXED, __HIP_MEMORY_SCOPE_AGENT); }
__device__ __forceinline__ unsigned xb_add(unsigned* p, unsigned v) { return __hip_atomic_fetch_add(p, v, __ATOMIC_RELAXED, __HIP_MEMORY_SCOPE_AGENT); }
__device__ __forceinline__ unsigned xb_xcc_id() { return (unsigned)__builtin_amdgcn_s_getreg((3 << 11) | 20) & 0xFu; }
#define XB_SPIN(cond, bar) do { unsigned _sp = 0; while (cond) { __builtin_amdgcn_s_sleep(1); \
    if ((++_sp & 255u) == 0u) { if (xb_ld(&(bar)[XB_TMO])) break; if (_sp > XB_SPIN_CAP) { atomicAdd(&(bar)[XB_TMO], 1u); break; } } } } while (0)
struct XcdBarrier { unsigned* bar; unsigned x; volatile LAS unsigned* st; };
__device__ __forceinline__ XcdBarrier xcd_barrier_post(unsigned* bar, volatile LAS unsigned* st) {
    XcdBarrier b; b.bar = bar; b.x = xb_xcc_id(); b.st = st;
    if (threadIdx.x == 0) (void)xb_add(&bar[XB_XCNT(b.x)], 1u);
    return b;
}
__device__ __forceinline__ void xcd_barrier_complete(unsigned* bar, unsigned x, unsigned& nloc, unsigned& nx) {
    const unsigned G = gridDim.x * gridDim.y * gridDim.z;
    unsigned sum, cnt, mine, sp = 0u;
    for (;;) {
        sum = 0u; cnt = 0u; mine = 0u;
#pragma unroll
        for (unsigned j = 0; j < 16; ++j) { const unsigned c = xb_ld(&bar[XB_XCNT(j)]); sum += c; cnt += (c > 0u) ? 1u : 0u; mine = (j == x) ? c : mine; }
        if (sum == G) break;
        __builtin_amdgcn_s_sleep(1);
        if ((++sp & 255u) == 0u) { if (xb_ld(&bar[XB_TMO])) break; if (sp > XB_SPIN_CAP) { atomicAdd(&bar[XB_TMO], 1u); break; } }
    }
    nloc = mine > 0u ? mine : 1u; nx = cnt > 0u ? cnt : 1u;
}
__device__ __forceinline__ void xcd_barrier(const XcdBarrier& b) {
    asm volatile("s_waitcnt vmcnt(0)" ::: "memory");
    __syncthreads();
    if (threadIdx.x == 0) {
        unsigned* bar = b.bar;
        __builtin_amdgcn_s_waitcnt(0);
        unsigned nloc = b.st[0], nx = b.st[1];
        if (nloc == 0u) { xcd_barrier_complete(bar, b.x, nloc, nx); b.st[0] = nloc; b.st[1] = nx; }
        const unsigned old = xb_add(&bar[XB_XSUB(b.x)], 1u);
        const unsigned gen = old / nloc;
        if (old + 1u == (gen + 1u) * nloc) {
            __builtin_amdgcn_fence(__ATOMIC_RELEASE, "agent");
            asm volatile("s_waitcnt vmcnt(0)" ::: "memory");
            const unsigned og = xb_add(&bar[XB_TOP], 1u);
            const unsigned tg = og / nx;
            if (og + 1u == (tg + 1u) * nx) xb_add(&bar[XB_TOPGEN], 1u);
            else XB_SPIN(xb_ld(&bar[XB_TOPGEN]) == tg, bar);
            __builtin_amdgcn_fence(__ATOMIC_ACQUIRE, "agent");
            xb_add(&bar[XB_XGEN(b.x)], 1u);
            asm volatile("s_waitcnt vmcnt(0)" ::: "memory");
        } else {
            XB_SPIN(xb_ld(&bar[XB_XGEN(b.x)]) == gen, bar);
            __builtin_amdgcn_fence(__ATOMIC_ACQUIRE, "agent");
            asm volatile("s_waitcnt vmcnt(0)" ::: "memory");
        }
    }
    __syncthreads();
}

__device__ __forceinline__ int tile_off(int row, int ks, int q) { return row * 128 + ((((ks << 2) | q) ^ ((row >> 1) & 7)) << 4); }

#define WAIT_V(n) asm volatile("s_waitcnt vmcnt(" #n ")" ::: "memory")
#define RAW_BARRIER() do { asm volatile("s_waitcnt lgkmcnt(0)" ::: "memory"); __builtin_amdgcn_s_barrier(); } while (0)
__device__ __forceinline__ void gemm_mainloop(const Params& p, f32x4 (&acc)[4][4], const bf16_t* __restrict__ A, int lda, const bf16_t* __restrict__ Bt, int ldb,
                                              int m0, int n0, int K, char* lds) {
  const int tid = opaque_tid(), l = tid & 63, w = tid >> 6, wm = w >> 1, wn = w & 1, lr = l & 15, q = l >> 4;
  const int vh = p.wave >> 2;
  const int nk = K >> 6;
  const int lrow = tid >> 3;
  const int lch = (tid & 7) ^ ((lrow >> 1) & 7);
  const bf16_t* ap = A + (size_t)(m0 + lrow) * lda + lch * 8;
  const bf16_t* bp = Bt + (size_t)(n0 + lrow) * ldb + lch * 8;
  char* ldst = lds + tid * 16;
  const char* ldsB = lds - vh * VLDS;
#define GEMM_STAGE(buf, kt)                                                                                                          \
  do {                                                                                                                               \
    _Pragma("unroll") for (int i = 0; i < 4; ++i)                                                                                    \
      __builtin_amdgcn_global_load_lds((const unsigned*)(ap + (size_t)i * 32 * lda + (kt) * 64), (__attribute__((address_space(3))) unsigned*)(ldst + (buf) * 32768 + i * 4096), 16, 0, 0);         \
    if (vh == 0) {                                                                                                                   \
      _Pragma("unroll") for (int i = 0; i < 4; ++i)                                                                                  \
        __builtin_amdgcn_global_load_lds((const unsigned*)(bp + (size_t)i * 32 * ldb + (kt) * 64), (__attribute__((address_space(3))) unsigned*)(ldst + (buf) * 32768 + 16384 + i * 4096), 16, 0, 0); \
    }                                                                                                                                \
  } while (0)
  WAIT_V(0);
  GEMM_STAGE(0, 0);
  WAIT_V(0);
  RAW_BARRIER();
  if (vh == 1) RAW_BARRIER();
  for (int kt = 0; kt < nk; ++kt) {
    if (kt + 1 < nk) GEMM_STAGE((kt + 1) & 1, kt + 1);
    const char* sa = lds + (kt & 1) * 32768;
    const char* sb = ldsB + (kt & 1) * 32768 + 16384;
    bf16x8 af[2][4], bfr[2][4];
#pragma unroll
    for (int ks = 0; ks < 2; ++ks) {
#pragma unroll
      for (int mi = 0; mi < 4; ++mi) af[ks][mi] = *(const bf16x8*)(sa + tile_off(wm * 64 + mi * 16 + lr, ks, q));
#pragma unroll
      for (int ni = 0; ni < 4; ++ni) bfr[ks][ni] = *(const bf16x8*)(sb + tile_off(wn * 64 + ni * 16 + lr, ks, q));
    }
    __builtin_amdgcn_sched_barrier(0);
    RAW_BARRIER();
    __builtin_amdgcn_sched_barrier(0);
    __builtin_amdgcn_s_setprio(1);
#pragma unroll
    for (int ks = 0; ks < 2; ++ks)
#pragma unroll
      for (int mi = 0; mi < 4; ++mi)
#pragma unroll
        for (int ni = 0; ni < 4; ++ni) acc[mi][ni] = MFMA(bfr[ks][ni], af[ks][mi], acc[mi][ni]);
    __builtin_amdgcn_s_setprio(0);
    WAIT_V(0);
    __builtin_amdgcn_sched_barrier(0);
    RAW_BARRIER();
    __builtin_amdgcn_sched_barrier(0);
  }
  if (vh == 0) RAW_BARRIER();
#undef GEMM_STAGE
}

__device__ __forceinline__ int tile_off32(int row, int q) { return row * 64 + ((q ^ (((row >> 3) & 1) << 1)) << 4); }
__device__ __forceinline__ void gemm_mainloop_w(const Params& p, f32x4 (&acc)[4][8], const bf16_t* __restrict__ A, int lda, const bf16_t* __restrict__ Bt, int ldb,
                                                int m0, int n0, int K, char* lds) {
  const int tid = opaque_tid(), l = tid & 63, w = tid >> 6, wm = w >> 1, wn = w & 1, lr = l & 15, q = l >> 4;
  const int nk = K >> 5;
  const int lrow = tid >> 2;
  const int lch = (tid & 3) ^ (((lrow >> 3) & 1) << 1);
  const bf16_t* ap = A + (size_t)(m0 + lrow) * lda + lch * 8;
  const bf16_t* bp = Bt + (size_t)(n0 + lrow) * ldb + lch * 8;
  char* ldst = lds + tid * 16;
#define GEMM_STAGE_W(buf, kt)                                                                                                        \
  do {                                                                                                                               \
    _Pragma("unroll") for (int i = 0; i < 2; ++i)                                                                                    \
      __builtin_amdgcn_global_load_lds((const unsigned*)(ap + (size_t)i * 64 * lda + (kt) * 32), (__attribute__((address_space(3))) unsigned*)(ldst + (buf) * 24576 + i * 4096), 16, 0, 0);        \
    _Pragma("unroll") for (int i = 0; i < 4; ++i)                                                                                    \
      __builtin_amdgcn_global_load_lds((const unsigned*)(bp + (size_t)i * 64 * ldb + (kt) * 32), (__attribute__((address_space(3))) unsigned*)(ldst + (buf) * 24576 + 8192 + i * 4096), 16, 0, 0); \
  } while (0)
  WAIT_V(0);
  GEMM_STAGE_W(0, 0);
  GEMM_STAGE_W(1, 1);
  int buf = 0, nbuf = 2;
  for (int kt = 0; kt < nk; ++kt) {
    if (kt < nk - 1) WAIT_V(6); else WAIT_V(0);
    RAW_BARRIER();
    if (kt + 2 < nk) GEMM_STAGE_W(nbuf, kt + 2);
    const char* sa = lds + buf * 24576;
    const char* sb = sa + 8192;
    bf16x8 af[4];
#pragma unroll
    for (int mi = 0; mi < 4; ++mi) af[mi] = *(const bf16x8*)(sa + tile_off32(wm * 64 + mi * 16 + lr, q));
#pragma unroll
    for (int nh = 0; nh < 2; ++nh) {
      bf16x8 bfr[4];
#pragma unroll
      for (int ni = 0; ni < 4; ++ni) bfr[ni] = *(const bf16x8*)(sb + tile_off32(wn * 128 + (nh * 4 + ni) * 16 + lr, q));
#pragma unroll
      for (int mi = 0; mi < 4; ++mi)
#pragma unroll
        for (int ni = 0; ni < 4; ++ni) acc[mi][nh * 4 + ni] = MFMA(bfr[ni], af[mi], acc[mi][nh * 4 + ni]);
      __builtin_amdgcn_sched_barrier(0);
    }
    buf = buf == 2 ? 0 : buf + 1;
    nbuf = nbuf == 2 ? 0 : nbuf + 1;
  }
  RAW_BARRIER();
#undef GEMM_STAGE_W
}

__device__ __forceinline__ void gemm_mainloop_8w(f32x4 (&acc)[8][4], const bf16_t* __restrict__ A, int lda, const bf16_t* __restrict__ Bt, int ldb,
                                                 int m0, int n0, int K, char* lds, int wave) {
  int tid = real_tid_(wave);
  const int l = tid & 63, w = tid >> 6, wm = w >> 2, wn = w & 3, lr = l & 15, q = l >> 4;
  const int nk = K >> 6;
  const int lrow = tid >> 3;
  const int lch = (tid & 7) ^ ((lrow >> 1) & 7);
  const bf16_t* ap = A + (size_t)(m0 + lrow) * lda + lch * 8;
  const bf16_t* bp = Bt + (size_t)(n0 + lrow) * ldb + lch * 8;
  char* ldst = lds + tid * 16;
#define GEMM_STAGE_8(buf, kt)                                                                                                        \
  do {                                                                                                                               \
    _Pragma("unroll") for (int i = 0; i < 4; ++i)                                                                                    \
      __builtin_amdgcn_global_load_lds((const unsigned*)(ap + (size_t)i * 64 * lda + (kt) * 64), (__attribute__((address_space(3))) unsigned*)(ldst + (buf) * 65536 + i * 8192), 16, 0, 0);         \
    _Pragma("unroll") for (int i = 0; i < 4; ++i)                                                                                    \
      __builtin_amdgcn_global_load_lds((const unsigned*)(bp + (size_t)i * 64 * ldb + (kt) * 64), (__attribute__((address_space(3))) unsigned*)(ldst + (buf) * 65536 + 32768 + i * 8192), 16, 0, 0); \
  } while (0)
#define HALF_STEP(KS)                                                                                                                \
  do {                                                                                                                               \
    bf16x8 bfr[4], af[8];                                                                                                            \
    _Pragma("unroll") for (int ni = 0; ni < 4; ++ni) bfr[ni] = *(const bf16x8*)(sb + tile_off(wn * 64 + ni * 16 + lr, KS, q));        \
    _Pragma("unroll") for (int mi = 0; mi < 8; ++mi) af[mi] = *(const bf16x8*)(sa + tile_off(wm * 128 + mi * 16 + lr, KS, q));        \
    if (KS == 1 && wm == 1) WAIT_V(0);     \
    __builtin_amdgcn_sched_barrier(0);                                                                                               \
    RAW_BARRIER();                                                                                                                   \
    __builtin_amdgcn_sched_barrier(0);                                                                                               \
    __builtin_amdgcn_s_setprio(1);                                                                                                   \
    _Pragma("unroll") for (int mi = 0; mi < 8; ++mi)                                                                                 \
      _Pragma("unroll") for (int ni = 0; ni < 4; ++ni) acc[mi][ni] = MFMA(bfr[ni], af[mi], acc[mi][ni]);                             \
    __builtin_amdgcn_s_setprio(0);                                                                                                   \
    if (KS == 1 && wm == 0) WAIT_V(0);                                                    \
    __builtin_amdgcn_sched_barrier(0);                                                                                               \
    RAW_BARRIER();                                                                                                                   \
    __builtin_amdgcn_sched_barrier(0);                                                                                               \
  } while (0)
  WAIT_V(0);
  GEMM_STAGE_8(0, 0);
  WAIT_V(0);
  RAW_BARRIER();
  if (wm == 1) RAW_BARRIER();
  for (int kt = 0; kt < nk; ++kt) {
    if (kt + 1 < nk) GEMM_STAGE_8((kt + 1) & 1, kt + 1);
    const char* sa = lds + (kt & 1) * 65536;
    const char* sb = sa + 32768;
    HALF_STEP(0);
    HALF_STEP(1);
  }
  if (wm == 0) RAW_BARRIER();
#undef HALF_STEP
#undef GEMM_STAGE_8
}

__device__ __forceinline__ void zero_acc(f32x4 (&acc)[4][4]) {
#pragma unroll
  for (int i = 0; i < 4; ++i)
#pragma unroll
    for (int j = 0; j < 4; ++j) acc[i][j] = zero4();
}

__device__ void convert_tile(const Params& p, const float* __restrict__ W, bf16_t* __restrict__ WT, int K, int N, int tk, int tn, bool perm, char* lds) {
  float* tile = (float*)lds;
  const int tid = opaque_tid();
  const int k0 = tk * 64, n0 = tn * 128;
  __syncthreads();
  {
    const int nn = (tid & 63) * 2, kb = tid >> 6;
    f32x2 v[16];
#pragma unroll
    for (int i = 0; i < 16; ++i) {
      v[i] = (f32x2){0.f, 0.f};
      if (n0 + nn < N) v[i] = *(const f32x2*)(W + (size_t)(k0 + i * 4 + kb) * N + n0 + nn);
    }
#pragma unroll
    for (int i = 0; i < 16; ++i) { tile[(i * 4 + kb) * 129 + nn] = v[i][0]; tile[(i * 4 + kb) * 129 + nn + 1] = v[i][1]; }
  }
  __syncthreads();
#pragma unroll
  for (int i = 0; i < 4; ++i) {
    int c = tid + i * 256, nn = c >> 3, kc = c & 7;
    int n = n0 + nn;
    if (n < N) {
      int dn = n;
      if (perm) dn = (n < 3584) ? n : ((n < 3600) ? (7680 + n - 3584) : (n - 16));
      bf16x8 o;
#pragma unroll
      for (int e = 0; e < 8; ++e) o[e] = (short)f2bf(tile[(kc * 8 + e) * 129 + nn]);
      *(bf16x8*)(WT + (size_t)dn * K + k0 + kc * 8) = o;
    }
  }
}

__device__ void phase_prologue(const Params& p, char* lds) {
  char* ws = opaque_ptr(p.ws);
  const int tid = opaque_tid();
  constexpr int T_IN = 16 * 61, T_BR = 8 * 8, T_OUT = 16 * 8, T_UP = 16 * 44, T_DN = 44 * 8;
  constexpr int T_LAYER = T_IN + 3 * T_BR + T_OUT + T_UP + T_DN;
  for (int it = VBLK; it < NL * T_LAYER; it += VGRID) {
    int l = it / T_LAYER, r = it % T_LAYER;
    if (r < T_IN) {
      convert_tile(p, p.w_in + (size_t)l * 1024 * NIN, (bf16_t*)(ws + OFF_WIN) + (size_t)l * NINP * 1024, 1024, NIN, r / 61, r % 61, true, lds);
    } else if ((r -= T_IN) < 3 * T_BR) {
      int br = r / T_BR; r %= T_BR;
      convert_tile(p, p.w_branch + (size_t)(l * 3 + br) * 512 * 1024, (bf16_t*)(ws + OFF_WBR) + (size_t)(l * 3 + br) * 1024 * 512, 512, 1024, r / 8, r % 8, false, lds);
    } else if ((r -= 3 * T_BR) < T_OUT) {
      convert_tile(p, p.w_out + (size_t)l * 1024 * 1024, (bf16_t*)(ws + OFF_WOUT) + (size_t)l * 1024 * 1024, 1024, 1024, r / 8, r % 8, false, lds);
    } else if ((r -= T_OUT) < T_UP) {
      convert_tile(p, p.w_up + (size_t)l * 1024 * UW, (bf16_t*)(ws + OFF_WUP) + (size_t)l * UW * 1024, 1024, UW, r / 44, r % 44, false, lds);
    } else {
      r -= T_UP;
      convert_tile(p, p.w_down + (size_t)l * DFF * 1024, (bf16_t*)(ws + OFF_WDN) + (size_t)l * 1024 * DFF, DFF, 1024, r / 8, r % 8, false, lds);
    }
  }
  for (int i = VBLK * 256 + tid; i < 2 * 262144; i += VGRID * 256) {
    const bool isv = i >= 262144;
    const int j = isv ? i - 262144 : i;
    const float* src = (isv ? p.cache_v : p.cache_k) + (size_t)j * 8;
    *(bf16x8*)((bf16_t*)(ws + (isv ? OFF_CVB : OFF_CKB)) + (size_t)j * 8) = ld_f32x8_bf(src);
  }
  {
    const int per = (NINP - NIN) * 1024 / 8;
    for (int i = VBLK * 256 + tid; i < NL * per; i += VGRID * 256) {
      int l = i / per, c = i % per;
      bf16x8 zv = zero8();
      *(bf16x8*)((bf16_t*)(ws + OFF_WIN) + (size_t)l * NINP * 1024 + (size_t)NIN * 1024 + (size_t)c * 8) = zv;
    }
  }
  if (VBLK == 0) {
    float* rt = (float*)(ws + OFF_ROPE);
    for (int i = tid; i < 1024; i += 256) {
      int pos = i >> 4, f = i & 15;
      float inv = powf(10000.f, -(float)f / 16.f);
      float ang = (float)pos * inv;
      rt[i * 2] = cosf(ang);
      rt[i * 2 + 1] = sinf(ang);
    }
  }
  {
    float* sc = (float*)lds;
    float* red = (float*)(lds + 20480);
    float* mod = (float*)(ws + OFF_MOD);
    for (int it = VBLK; it < NL * 96; it += VGRID) {
      int l = it / 96, cb = it % 96;
      __syncthreads();
      for (int i = tid; i < 5120; i += 256) {
        int c = i >> 10, k = i & 1023;
        float v = (c == 0) ? p.c_ctx[k] : p.c[(c - 1) * 1024 + k];
        sc[i] = siluf(v);
      }
      __syncthreads();
      int kg = tid >> 6, col = cb * 64 + (tid & 63);
      float a0 = 0, a1 = 0, a2 = 0, a3 = 0, a4 = 0;
      const float* wp = p.w_mod + ((size_t)l * 1024 + kg * 256) * 6144 + col;
#pragma unroll 16
      for (int k = 0; k < 256; ++k) {
        float wv = wp[(size_t)k * 6144];
        int kk = kg * 256 + k;
        a0 += sc[kk] * wv; a1 += sc[1024 + kk] * wv; a2 += sc[2048 + kk] * wv; a3 += sc[3072 + kk] * wv; a4 += sc[4096 + kk] * wv;
      }
      int lc = tid & 63;
      red[(kg * 5 + 0) * 64 + lc] = a0; red[(kg * 5 + 1) * 64 + lc] = a1; red[(kg * 5 + 2) * 64 + lc] = a2; red[(kg * 5 + 3) * 64 + lc] = a3; red[(kg * 5 + 4) * 64 + lc] = a4;
      __syncthreads();
      if (tid < 64) {
        float b = p.b_mod[l * 6144 + col];
#pragma unroll
        for (int c = 0; c < 5; ++c) {
          float s = red[(0 * 5 + c) * 64 + tid] + red[(1 * 5 + c) * 64 + tid] + red[(2 * 5 + c) * 64 + tid] + red[(3 * 5 + c) * 64 + tid];
          mod[(size_t)(l * 5 + c) * 6144 + col] = s + b;
        }
      }
    }
  }
}

__device__ void phase_norm(const Params& p, int l, int which  , bool first) {
  char* ws = opaque_ptr(p.ws);
  float* x = (float*)(ws + OFF_X);
  bf16_t* H = (bf16_t*)(ws + OFF_H);
  const float* mod = (const float*)(ws + OFF_MOD);
  const int tid = opaque_tid();
  const int lane = tid & 63, w = tid >> 6;
  for (int row = VBLK * 4 + w; row < NTOK; row += VGRID * 4) {
    const float* src = first ? (row < NCTX ? p.x_prompt + (size_t)row * 1024 : p.x_sample + (size_t)(row - NCTX) * 1024) : x + (size_t)row * 1024;
    f32x4 v[4];
    float ss = 0.f;
#pragma unroll
    for (int i = 0; i < 4; ++i) { v[i] = *(const f32x4*)(src + i * 256 + lane * 4); ss += v[i][0] * v[i][0] + v[i][1] * v[i][1] + v[i][2] * v[i][2] + v[i][3] * v[i][3]; }
#pragma unroll
    for (int o = 1; o < 64; o <<= 1) ss += __shfl_xor(ss, o);
    float rstd = rsqrtf(ss * (1.f / 1024.f) + 1e-6f);
    if (which == 2) {
      float* dst = p.out + (size_t)row * 1024;
#pragma unroll
      for (int i = 0; i < 4; ++i) {
        f32x4 g = *(const f32x4*)(p.final_g + i * 256 + lane * 4);
        f32x4 o = {v[i][0] * rstd * g[0], v[i][1] * rstd * g[1], v[i][2] * rstd * g[2], v[i][3] * rstd * g[3]};
        *(f32x4*)(dst + i * 256 + lane * 4) = o;
      }
    } else {
      const float* mrow = mod + (size_t)(l * 5 + cond_of(row)) * 6144 + (which == 0 ? 0 : 3072);
#pragma unroll
      for (int i = 0; i < 4; ++i) {
        int col = i * 256 + lane * 4;
        f32x4 sh = *(const f32x4*)(mrow + col), sc = *(const f32x4*)(mrow + 1024 + col);
        *(bf16x4*)(H + (size_t)row * 1024 + col) = pack4(v[i][0] * rstd * (1.f + sc[0]) + sh[0], v[i][1] * rstd * (1.f + sc[1]) + sh[1],
                                                         v[i][2] * rstd * (1.f + sc[2]) + sh[2], v[i][3] * rstd * (1.f + sc[3]) + sh[3]);
        if (first) *(f32x4*)(x + (size_t)row * 1024 + col) = v[i];
      }
    }
  }
}

__device__ void phase_init(const Params& p) {
  char* ws = p.ws;
  float* x = (float*)(ws + OFF_X);
  bf16_t* A1 = (bf16_t*)(ws + OFF_A1);
  float* ssp = (float*)(ws + OFF_SSP);
  const float* mod = (const float*)(ws + OFF_MOD);
  const int tid = opaque_tid();
  const int lane = tid & 63, w = tid >> 6;
  for (int row = VBLK * 4 + w; row < NTOK; row += VGRID * 4) {
    const float* src = row < NCTX ? p.x_prompt + (size_t)row * 1024 : p.x_sample + (size_t)(row - NCTX) * 1024;
    const float* mrow = mod + (size_t)(cond_of(row)) * 6144 + 1024;
    float ss = 0.f;
#pragma unroll
    for (int i = 0; i < 4; ++i) {
      int col = i * 256 + lane * 4;
      f32x4 v = *(const f32x4*)(src + col);
      ss += v[0] * v[0] + v[1] * v[1] + v[2] * v[2] + v[3] * v[3];
      f32x4 sc = *(const f32x4*)(mrow + col);
      *(f32x4*)(x + (size_t)row * 1024 + col) = v;
      *(bf16x4*)(A1 + (size_t)row * 1024 + col) = pack4(v[0] * (1.f + sc[0]), v[1] * (1.f + sc[1]), v[2] * (1.f + sc[2]), v[3] * (1.f + sc[3]));
    }
#pragma unroll
    for (int o = 1; o < 64; o <<= 1) ss += __shfl_xor(ss, o);
    if (lane < 8) ssp[(size_t)lane * NTOK + row] = lane == 0 ? ss : 0.f;
  }
  {
    const int lr = lane & 15, q = lane >> 4;
    constexpr int TPL = (NINP + UW) / 16;
    for (int ct = VBLK * 4 + w; ct < NL * TPL; ct += VGRID * 4) {
      const int l = ct / TPL, r = ct % TPL;
      const bool up = r >= NINP / 16;
      const int n0 = up ? (r - NINP / 16) * 16 : r * 16;
      const bf16_t* wr = (up ? (const bf16_t*)(ws + OFF_WUP) + ((size_t)l * UW + n0 + lr) * 1024 : (const bf16_t*)(ws + OFF_WIN) + ((size_t)l * NINP + n0 + lr) * 1024) + q * 8;
      const float* shb = mod + (size_t)(l * 5 + (lr < 5 ? lr : 4)) * 6144 + (up ? 3072 : 0) + q * 8;
      f32x4 acc = zero4();
#pragma unroll 4
      for (int ks = 0; ks < 32; ++ks) {
        bf16x8 bfrag = *(const bf16x8*)(wr + ks * 32);
        bf16x8 afrag = ld_f32x8_bf(shb + ks * 32);
        if (lr >= 5) afrag = zero8();
        acc = MFMA(afrag, bfrag, acc);
      }
      float* outp = up ? (float*)(ws + OFF_SHW2) + (size_t)(l * 5) * UW + n0 + lr : (float*)(ws + OFF_SHW1) + (size_t)(l * 5) * NINP + n0 + lr;
      const int W = up ? UW : NINP;
      if (q == 0) { outp[0] = acc[0]; outp[W] = acc[1]; outp[2 * W] = acc[2]; outp[3 * W] = acc[3]; }
      if (q == 1) outp[4 * W] = acc[0];
    }
  }
}

__device__ __forceinline__ float row_rstd(const float* ssp, int m) {
  float s = 0.f;
#pragma unroll
  for (int j = 0; j < 8; ++j) s += ssp[(size_t)j * NTOK + m];
  return rsqrtf(s * (1.f / 1024.f) + 1e-6f);
}

__device__ void phase_inproj(const Params& p, int l, char* lds_all) {
  char* ws = opaque_ptr(p.ws);
  const bf16_t* H = (const bf16_t*)(ws + OFF_A1);
  const bf16_t* Wt = (const bf16_t*)(ws + OFF_WIN) + (size_t)l * NINP * 1024;
  bf16_t* z = (bf16_t*)(ws + OFF_Z);
  float* gp = (float*)(ws + OFF_GP);
  const float* rope = (const float*)(ws + OFF_ROPE);
  int tid = real_tid_(p.wave);
  const int lane = tid & 63, w = tid >> 6, wm = w >> 2, wn = w & 3, lr = lane & 15, q = lane >> 4;
  float* rs_lds = (float*)(lds_all + 131072);
  float* sh_lds = (float*)(lds_all + 131072 + 1024);
  int par = 0, cur_mt = -1;
  for (int it = blockIdx.x; it < 32 * 31; it += gridDim.x, par ^= 1) {
    const int ntw = it >> 5, mt = it & 31;
    const int m0 = mt * 256, n0 = ntw * 256;
    if (mt != cur_mt) {
      __syncthreads();
      if (tid < 256) rs_lds[tid] = row_rstd((const float*)(ws + OFF_SSP), m0 + tid);
      cur_mt = mt;
    }
    if (tid < 64) *(f32x4*)(sh_lds + par * 256 + tid * 4) = *(const f32x4*)((const float*)(ws + OFF_SHW1) + (size_t)(l * 5 + cond_of(m0)) * NINP + n0 + tid * 4);
    f32x4 acc[8][4];
#pragma unroll
    for (int i = 0; i < 8; ++i)
#pragma unroll
      for (int j = 0; j < 4; ++j) acc[i][j] = zero4();
    gemm_mainloop_8w(acc, H, 1024, Wt, 1024, m0, n0, 1024, lds_all, p.wave);
    int lro = lr; asm volatile("" : "+v"(lro));
    const bool lat = m0 >= NCTX;
    const int nc0 = n0 + wn * 64;
    const int nt = nc0 >> 7, sub = (nc0 >> 6) & 1;
    const bool active = !(nt > 60 || (nt == 60 && sub == 1));
    if (active) {
      const float* shl = sh_lds + par * 256 + wn * 64 + q * 4;
      if (nt == 60) {
#pragma unroll
        for (int mi = 0; mi < 8; ++mi) {
          const int m = m0 + wm * 128 + mi * 16 + lro;
          const float rs = rs_lds[wm * 128 + mi * 16 + lro];
          f32x4 sv = *(const f32x4*)shl;
          f32x4 o;
#pragma unroll
          for (int r = 0; r < 4; ++r) {
            int j = q * 4 + r;
            float v = acc[mi][0][r] * rs + sv[r] + p.ml_gate_b[l * 16 + j];
            o[r] = (j < 8) ? v : logsigf(v);
          }
          *(f32x4*)(gp + (size_t)m * 16 + q * 4) = o;
        }
      } else {
        const int mode = (nt < 24) ? 0 : ((nt < 28) ? 1 : ((nt < 36) ? 2 : 1));
        const bool do_rope = lat && nt < 8;
        const bool do_cache = !lat && nt >= 4 && nt < 12;
        float* cdst = p.out + ((nt < 8) ? O_CK : O_CV);
        const int hh = (nt - 4) & 3;
        char* stg = lds_all + w * 8192;
#pragma unroll
        for (int mh = 0; mh < 2; ++mh) {
#pragma unroll
          for (int mq = 0; mq < 4; ++mq) {
            const int mi = mh * 4 + mq;
            const int m = m0 + wm * 128 + mi * 16 + lro;
            const float rs = rs_lds[wm * 128 + mi * 16 + lro];
#pragma unroll
            for (int ni = 0; ni < 4; ++ni) {
              f32x4 sv = *(const f32x4*)(shl + ni * 16);
              acc[mi][ni][0] = acc[mi][ni][0] * rs + sv[0]; acc[mi][ni][1] = acc[mi][ni][1] * rs + sv[1];
              acc[mi][ni][2] = acc[mi][ni][2] * rs + sv[2]; acc[mi][ni][3] = acc[mi][ni][3] * rs + sv[3];
            }
            if (do_rope) {
              const int t = (m - NCTX) & 1023;
#pragma unroll
              for (int a = 0; a < 2; ++a) {
                const int pos = (a == 0) ? (t >> 6) : (t & 63);
#pragma unroll
                for (int r = 0; r < 4; ++r) {
                  const int f = q * 4 + r;
                  const float c = rope[(pos * 16 + f) * 2], sn = rope[(pos * 16 + f) * 2 + 1];
                  const float x1 = acc[mi][2 * a][r], x2 = acc[mi][2 * a + 1][r];
                  acc[mi][2 * a][r] = x1 * c - x2 * sn;
                  acc[mi][2 * a + 1][r] = x1 * sn + x2 * c;
                }
              }
            }
            if (do_cache) {
              const int b = m >> 8, t = m & 255;
              float* rowp = cdst + ((size_t)((b * 4 + l) * 4 + hh) * 256 + t) * 128 + sub * 64 + q * 4;
#pragma unroll
              for (int ni = 0; ni < 4; ++ni) *(f32x4*)(rowp + ni * 16) = acc[mi][ni];
            }
#pragma unroll
            for (int ni = 0; ni < 4; ++ni) {
              f32x4 v = acc[mi][ni];
              if (mode == 1) { v[0] = sigmf(v[0]); v[1] = sigmf(v[1]); v[2] = sigmf(v[2]); v[3] = sigmf(v[3]); }
              else if (mode == 2) { v[0] = geluf(v[0]); v[1] = geluf(v[1]); v[2] = geluf(v[2]); v[3] = geluf(v[3]); }
              *(bf16x4*)(stg + (mq * 16 + lro) * 128 + ((((ni << 1) | (q >> 1)) ^ (lro & 7)) << 4) + ((q & 1) << 3)) = pack4(v[0], v[1], v[2], v[3]);
            }
            __builtin_amdgcn_sched_barrier(0);
          }
#pragma unroll
          for (int i = 0; i < 8; ++i) {
            const int r = i * 8 + (lane >> 3), c = lane & 7;
            bf16x8 v = *(const bf16x8*)(stg + r * 128 + ((c ^ (r & 7)) << 4));
            *(bf16x8*)(z + (size_t)(m0 + wm * 128 + mh * 64 + r) * ZW + nc0 + c * 8) = v;
          }
        }
      }
    }
    __syncthreads();
  }
}

__device__ void attn_item(const Params& p, int l, int item, char* lds, int split, char* lds_all) {
  char* ws = opaque_ptr(p.ws);
  const bf16_t* z = (const bf16_t*)(ws + OFF_Z);
  bf16_t* yda = (bf16_t*)(ws + OFF_YDA);
  int seq, h, qt;
  if (item < 256) { seq = 16 + (item >> 6); h = (item >> 4) & 3; qt = item & 15; }
  else { int i2 = item - 256; seq = i2 >> 4; h = (i2 >> 2) & 3; qt = i2 & 3; }
  const bool lat = seq >= 16;
  const int rowbase = lat ? NCTX + (seq - 16) * 1024 : seq * 256;
  const int nkt_all = lat ? 20 : 4;
  const int vh = p.wave >> 2;
  const int kt0 = split ? vh * (nkt_all >> 1) : 0;
  const int nkt = split ? kt0 + (nkt_all >> 1) : nkt_all;
  const int tid = opaque_tid(), lane = tid & 63, w = tid >> 6, lr = lane & 15, q = lane >> 4;
  const int qrow = rowbase + qt * 64 + w * 16 + lr;
  bf16x8 qf[2][2];
#pragma unroll
  for (int sub = 0; sub < 2; ++sub)
#pragma unroll
    for (int ks = 0; ks < 2; ++ks) qf[sub][ks] = *(const bf16x8*)(z + (size_t)qrow * ZW + ZQ + h * 128 + sub * 64 + ks * 32 + q * 8);
  f32x4 o[2][8];
#pragma unroll
  for (int sub = 0; sub < 2; ++sub)
#pragma unroll
    for (int vt = 0; vt < 8; ++vt) o[sub][vt] = zero4();
  float mrun[2] = {-1e30f, -1e30f}, lrun[2] = {0.f, 0.f};
  const float sc = 0.125f * 1.4426950408889634f;
  const bf16_t* ckb = (const bf16_t*)(ws + OFF_CKB) + (size_t)(((seq - 16) * 4 + l) * 4 + h) * 32768;
  const bf16_t* cvb = (const bf16_t*)(ws + OFF_CVB) + (size_t)(((seq - 16) * 4 + l) * 4 + h) * 32768;
  bf16x8 rk[4], rv[4];
#define ATT_LOAD(kt_)                                                                                                        \
  do {                                                                                                                       \
    const int kt__ = (kt_);                                                                                                  \
    if (lat && kt__ < 4) {                                                                                                   \
      _Pragma("unroll") for (int i = 0; i < 4; ++i) {                                                                        \
        int idx = tid + i * 256;                                                                                             \
        rk[i] = *(const bf16x8*)(ckb + (size_t)(kt__ * 64 + (idx >> 4)) * 128 + (idx & 15) * 8);                             \
        rv[i] = *(const bf16x8*)(cvb + (size_t)(kt__ * 64 + (idx >> 4)) * 128 + (idx & 15) * 8);                             \
      }                                                                                                                      \
    } else {                                                                                                                 \
      const int r0 = lat ? rowbase + (kt__ - 4) * 64 : rowbase + kt__ * 64;                                                  \
      _Pragma("unroll") for (int i = 0; i < 4; ++i) {                                                                        \
        int idx = tid + i * 256;                                                                                             \
        rk[i] = *(const bf16x8*)(z + (size_t)(r0 + (idx >> 4)) * ZW + ZK + h * 128 + (idx & 15) * 8);                        \
        rv[i] = *(const bf16x8*)(z + (size_t)(r0 + (idx >> 4)) * ZW + ZV + h * 128 + (idx & 15) * 8);                        \
      }                                                                                                                      \
    }                                                                                                                        \
  } while (0)
#define ATT_STORE(buf_)                                                                                                      \
  do {                                                                                                                       \
    bf16_t* Ks_ = (bf16_t*)(lds + (buf_) * 34816);                                                                           \
    bf16_t* Vt_ = Ks_ + 64 * 136;                                                                                            \
    _Pragma("unroll") for (int i = 0; i < 4; ++i) {                                                                          \
      int idx = tid + i * 256;                                                                                               \
      *(bf16x8*)(Ks_ + (idx >> 4) * 136 + (idx & 15) * 8) = rk[i];                                                           \
      *(bf16x8*)(Vt_ + (idx >> 4) * 136 + (idx & 15) * 8) = rv[i];              \
    }                                                                                                                        \
  } while (0)
  __syncthreads();
  ATT_LOAD(kt0);
  ATT_STORE(kt0 & 1);
  __syncthreads();
  for (int kt = kt0; kt < nkt; ++kt) {
    if (kt + 1 < nkt) ATT_LOAD(kt + 1);
    const bf16_t* Ks = (const bf16_t*)(lds + (kt & 1) * 34816);
    const bf16_t* Vt = Ks + 64 * 136;
    f32x4 s[2][4];
#pragma unroll
    for (int sub = 0; sub < 2; ++sub)
#pragma unroll
      for (int k16 = 0; k16 < 4; ++k16) {
        f32x4 a = zero4();
#pragma unroll
        for (int ks = 0; ks < 2; ++ks) {
          bf16x8 kf = *(const bf16x8*)(Ks + (k16 * 16 + lr) * 136 + sub * 64 + ks * 32 + q * 8);
          a = MFMA(kf, qf[sub][ks], a);
        }
        s[sub][k16] = a;
      }
#pragma unroll
    for (int sub = 0; sub < 2; ++sub) {
      float mx = -1e30f;
#pragma unroll
      for (int k16 = 0; k16 < 4; ++k16)
#pragma unroll
        for (int r = 0; r < 4; ++r) mx = fmaxf(mx, s[sub][k16][r]);
      mx *= sc;
      mx = fmaxf(mx, __shfl_xor(mx, 16));
      mx = fmaxf(mx, __shfl_xor(mx, 32));
      float mn = fmaxf(mrun[sub], mx);
      float alpha = __builtin_amdgcn_exp2f(mrun[sub] - mn);
      mrun[sub] = mn;
      float ps = 0.f;
#pragma unroll
      for (int k16 = 0; k16 < 4; ++k16)
#pragma unroll
        for (int r = 0; r < 4; ++r) { float pv = __builtin_amdgcn_exp2f(s[sub][k16][r] * sc - mn); s[sub][k16][r] = pv; ps += pv; }
      lrun[sub] = lrun[sub] * alpha + ps;
#pragma unroll
      for (int vt = 0; vt < 8; ++vt) { o[sub][vt][0] *= alpha; o[sub][vt][1] *= alpha; o[sub][vt][2] *= alpha; o[sub][vt][3] *= alpha; }
    }
#pragma unroll
    for (int a = 0; a < 2; ++a) {
      bf16x8 pf0 = pack8(s[0][2 * a], s[0][2 * a + 1]);
      bf16x8 pf1 = pack8(s[1][2 * a], s[1][2 * a + 1]);
#pragma unroll
      for (int vt = 0; vt < 8; ++vt) {
        typedef short s4v __attribute__((ext_vector_type(4)));
        const bf16_t* va0 = Vt + (a * 32 + q * 4 + (lr >> 2)) * 136 + vt * 16 + 4 * (lr & 3);
        bf16x4 v0 = __builtin_amdgcn_ds_read_tr16_b64_v4i16((__attribute__((address_space(3))) s4v*)va0);
        bf16x4 v1 = __builtin_amdgcn_ds_read_tr16_b64_v4i16((__attribute__((address_space(3))) s4v*)(va0 + 16 * 136));
        bf16x8 vf = cat4(v0, v1);
        o[0][vt] = MFMA(vf, pf0, o[0][vt]);
        o[1][vt] = MFMA(vf, pf1, o[1][vt]);
      }
    }
    if (kt + 1 < nkt) ATT_STORE((kt + 1) & 1);
    __syncthreads();
  }
#undef ATT_LOAD
#undef ATT_STORE
  if (split) {
    float* xch = (float*)(lds_all + VLDS);
    if (vh == 1) {
#pragma unroll
      for (int sub = 0; sub < 2; ++sub) {
#pragma unroll
        for (int vt = 0; vt < 8; ++vt)
#pragma unroll
          for (int r = 0; r < 4; ++r) xch[(w * 68 + sub * 32 + vt * 4 + r) * 64 + lane] = o[sub][vt][r];
        xch[(w * 68 + 64 + sub) * 64 + lane] = mrun[sub];
        xch[(w * 68 + 66 + sub) * 64 + lane] = lrun[sub];
      }
    }
    __syncthreads();
    if (vh == 1) return;
#pragma unroll
    for (int sub = 0; sub < 2; ++sub) {
      const float mB = xch[(w * 68 + 64 + sub) * 64 + lane], lB = xch[(w * 68 + 66 + sub) * 64 + lane];
      const float mn = fmaxf(mrun[sub], mB);
      const float aA = __builtin_amdgcn_exp2f(mrun[sub] - mn), aB = __builtin_amdgcn_exp2f(mB - mn);
      lrun[sub] = lrun[sub] * aA + lB * aB;
#pragma unroll
      for (int vt = 0; vt < 8; ++vt)
#pragma unroll
        for (int r = 0; r < 4; ++r) o[sub][vt][r] = o[sub][vt][r] * aA + xch[(w * 68 + sub * 32 + vt * 4 + r) * 64 + lane] * aB;
    }
  }
  float l1 = lrun[0], l2 = lrun[1];
  l1 += __shfl_xor(l1, 16); l1 += __shfl_xor(l1, 32);
  l2 += __shfl_xor(l2, 16); l2 += __shfl_xor(l2, 32);
  float d1 = p.da_lambda[(l * 4 + 0) * 64 + lane] * p.da_lambda[(l * 4 + 1) * 64 + lane];
  float d2 = p.da_lambda[(l * 4 + 2) * 64 + lane] * p.da_lambda[(l * 4 + 3) * 64 + lane];
#pragma unroll
  for (int of = 1; of < 64; of <<= 1) { d1 += __shfl_xor(d1, of); d2 += __shfl_xor(d2, of); }
  int li = l; asm volatile("" : "+v"(li)); const float lf = (float)li;
  const float lam_init = 0.8f - 0.6f * expf(-0.3f * lf);
  const float lam = expf(d1) - expf(d2) + lam_init;
  const float i1 = 1.f / l1, i2 = lam / l2;
  float ss = 0.f;
#pragma unroll
  for (int vt = 0; vt < 8; ++vt)
#pragma unroll
    for (int r = 0; r < 4; ++r) { float v = o[0][vt][r] * i1 - o[1][vt][r] * i2; o[0][vt][r] = v; ss += v * v; }
  ss += __shfl_xor(ss, 16); ss += __shfl_xor(ss, 32);
  const float rstd = rsqrtf(ss * (1.f / 128.f) + 1e-6f) * (1.f - lam_init);
#pragma unroll
  for (int vt = 0; vt < 8; ++vt) {
    f32x4 g = *(const f32x4*)(p.da_norm_g + l * 128 + vt * 16 + q * 4);
    *(bf16x4*)(yda + (size_t)qrow * 512 + h * 128 + vt * 16 + q * 4) =
        pack4(o[0][vt][0] * rstd * g[0], o[0][vt][1] * rstd * g[1], o[0][vt][2] * rstd * g[2], o[0][vt][3] * rstd * g[3]);
  }
}

__device__ __forceinline__ void conv_silu8(const Params& p, int l, const bf16_t* z, int row, bool hp, bool hn, int zcol, int cch, float scale, float (&out)[8]) {
  bf16x8 x1 = *(const bf16x8*)(z + (size_t)row * ZW + zcol);
  bf16x8 x0 = zero8(), x2 = zero8();
  if (hp) x0 = *(const bf16x8*)(z + (size_t)(row - 1) * ZW + zcol);
  if (hn) x2 = *(const bf16x8*)(z + (size_t)(row + 1) * ZW + zcol);
  const float* cw = p.ml_conv_w + (size_t)l * 3 * 1024 + cch;
  const float* cb = p.ml_conv_b + (size_t)l * 1024 + cch;
  float w0[8], w1[8], w2[8], bv[8];
  {
    f32x4 t0 = *(const f32x4*)cw, t1 = *(const f32x4*)(cw + 4), t2 = *(const f32x4*)(cw + 1024), t3 = *(const f32x4*)(cw + 1028);
    f32x4 t4 = *(const f32x4*)(cw + 2048), t5 = *(const f32x4*)(cw + 2052), t6 = *(const f32x4*)cb, t7 = *(const f32x4*)(cb + 4);
#pragma unroll
    for (int e = 0; e < 4; ++e) { w0[e] = t0[e]; w0[4 + e] = t1[e]; w1[e] = t2[e]; w1[4 + e] = t3[e]; w2[e] = t4[e]; w2[4 + e] = t5[e]; bv[e] = t6[e]; bv[4 + e] = t7[e]; }
  }
#pragma unroll
  for (int e = 0; e < 8; ++e) {
    float v = w0[e] * bfs(x0[e]) + w1[e] * bfs(x1[e]) + w2[e] * bfs(x2[e]) + bv[e];
    out[e] = siluf(v) * scale;
  }
}

__device__ __forceinline__ void ml_gate_scan(const float* gp, int row0, int h, int dir, int lane, float* bb, float* cc, float* am, float* gout) {
  const int j0 = 2 * lane, j1 = 2 * lane + 1;
  const int t0 = dir == 0 ? j0 : 127 - j0, t1 = dir == 0 ? j1 : 127 - j1;
  const float ig0 = gp[(size_t)(row0 + t0) * 16 + dir * 4 + h], ig1 = gp[(size_t)(row0 + t1) * 16 + dir * 4 + h];
  const float lf0 = gp[(size_t)(row0 + t0) * 16 + 8 + dir * 4 + h], lf1 = gp[(size_t)(row0 + t1) * 16 + 8 + dir * 4 + h];
  const float pair = lf0 + lf1;
  float x = pair;
#pragma unroll
  for (int off = 1; off < 64; off <<= 1) { float v = __shfl_up(x, off); if (lane >= off) x += v; }
  const float b0 = (x - pair) + lf0, b1 = b0 + lf1;
  const float c0 = ig0 - b0, c1 = ig1 - b1;
  float pm = fmaxf(c0, c1);
#pragma unroll
  for (int off = 1; off < 64; off <<= 1) { float v = __shfl_up(pm, off); if (lane >= off) pm = fmaxf(pm, v); }
  float ex = __shfl_up(pm, 1);
  if (lane == 0) ex = -1e30f;
  const float a0 = fmaxf(ex, c0), a1 = fmaxf(a0, c1);
  bb[t0] = b0; bb[t1] = b1; cc[t0] = c0; cc[t1] = c1; am[t0] = a0; am[t1] = a1;
  gout[t0] = b0; gout[t1] = b1; gout[128 + t0] = c0; gout[128 + t1] = c1; gout[256 + t0] = a0; gout[256 + t1] = a1;
}

__device__ void mlu_item(const Params& p, int l, int item, char* lds) {
  char* ws = opaque_ptr(p.ws);
  const bf16_t* z = (const bf16_t*)(ws + OFF_Z);
  const float* gp = (const float*)(ws + OFF_GP);
  bf16_t* mqc = (bf16_t*)(ws + OFF_MQC);
  bf16_t* mkc = (bf16_t*)(ws + OFF_MKC);
  const int h = item & 3, chunk = item >> 2;
  const int row0 = chunk * 128;
  const int T = row0 < NCTX ? 256 : 1024;
  const int seqbase = row0 < NCTX ? (row0 & ~255) : NCTX + ((row0 - NCTX) & ~1023);
  const int tpos0 = row0 - seqbase;
  const int tid = opaque_tid(), lane = tid & 63, w = tid >> 6, lr = lane & 15, q = lane >> 4;
  bf16_t* KT = (bf16_t*)lds;
  bf16_t* Vt = (bf16_t*)(lds + 34816);
  float* fl = (float*)(lds + 69632);
  __syncthreads();
  if (w < 2) ml_gate_scan(gp, row0, h, w, lane, fl + w * 128, fl + 256 + w * 128, fl + 512 + w * 128, (float*)(ws + OFF_GB) + (size_t)((chunk * 4 + h) * 2 + w) * 384);
#pragma unroll 4
  for (int i = 0; i < 8; ++i) {
    const int idx = tid + i * 256;
    const int s = idx >> 4, dch = idx & 15;
    const int row = row0 + s;
    const bool hp = (tpos0 + s) > 0, hn = (tpos0 + s) < T - 1;
    float kv[8];
    conv_silu8(p, l, z, row, hp, hn, MK + h * 128 + dch * 8, 512 + h * 128 + dch * 8, 0.08838834764831845f, kv);
    bf16x8 vv = *(const bf16x8*)(z + (size_t)row * ZW + MV + h * 128 + dch * 8);
    bf16x8 ko;
#pragma unroll
    for (int e = 0; e < 8; ++e) ko[e] = (short)f2bf(kv[e]);
    *(bf16x8*)(KT + s * 136 + dch * 8) = ko;
    *(bf16x8*)(Vt + s * 136 + dch * 8) = vv;
    *(bf16x8*)(mkc + (size_t)row * 512 + h * 128 + dch * 8) = ko;
    float qv[8];
    conv_silu8(p, l, z, row, hp, hn, MQ + h * 128 + dch * 8, h * 128 + dch * 8, 1.f, qv);
    bf16x8 qo;
#pragma unroll
    for (int e = 0; e < 8; ++e) qo[e] = (short)f2bf(qv[e]);
    *(bf16x8*)(mqc + (size_t)row * 512 + h * 128 + dch * 8) = qo;
  }
  __syncthreads();
  const bf16x8 ones = {0x3F80, 0x3F80, 0x3F80, 0x3F80, 0x3F80, 0x3F80, 0x3F80, 0x3F80};
#pragma unroll 1
  for (int dir = 0; dir < 2; ++dir) {
    const float* bb = fl + dir * 128;
    const float* cc = fl + 256 + dir * 128;
    const float* am = fl + 512 + dir * 128;
    const float B_L = dir == 0 ? bb[127] : bb[0];
    const float amax = dir == 0 ? am[127] : am[0];
    const int uitem = item * 2 + dir;
    float* Uc = (float*)(ws + OFF_UC) + (size_t)uitem * 16384;
    float* Un = (float*)(ws + OFF_UN) + (size_t)uitem * 128;
    float* Usc = (float*)(ws + OFF_USC) + uitem * 2;
    f32x4 acc[2][8], nacc[2];
#pragma unroll
    for (int dt = 0; dt < 2; ++dt) { nacc[dt] = zero4();
#pragma unroll
      for (int vt = 0; vt < 8; ++vt) acc[dt][vt] = zero4(); }
#pragma unroll
    for (int ks = 0; ks < 4; ++ks) {
      f32x4 g0 = *(const f32x4*)(cc + ks * 32 + q * 8), g1 = *(const f32x4*)(cc + ks * 32 + q * 8 + 4);
      float gg[8];
#pragma unroll
      for (int e = 0; e < 4; ++e) { gg[e] = __expf(g0[e] - amax); gg[4 + e] = __expf(g1[e] - amax); }
      bf16x8 af[2];
#pragma unroll
      for (int dt = 0; dt < 2; ++dt) {
        const bf16_t* ka = KT + (ks * 32 + q * 8 + (lr >> 2)) * 136 + w * 32 + dt * 16 + 4 * (lr & 3);
        bf16x8 kf = cat4(lds_tr4(ka), lds_tr4(ka + 4 * 136));
#pragma unroll
        for (int e = 0; e < 8; ++e) af[dt][e] = (short)f2bf(bfs(kf[e]) * gg[e]);
      }
#pragma unroll
      for (int dt = 0; dt < 2; ++dt) nacc[dt] = MFMA(af[dt], ones, nacc[dt]);
#pragma unroll
      for (int vt = 0; vt < 8; ++vt) {
        const bf16_t* va = Vt + (ks * 32 + q * 8 + (lr >> 2)) * 136 + vt * 16 + 4 * (lr & 3);
        bf16x8 bfr = cat4(lds_tr4(va), lds_tr4(va + 4 * 136));
#pragma unroll
        for (int dt = 0; dt < 2; ++dt) acc[dt][vt] = MFMA(af[dt], bfr, acc[dt][vt]);
      }
      __builtin_amdgcn_sched_barrier(0);
    }
#pragma unroll
    for (int dt = 0; dt < 2; ++dt)
#pragma unroll
      for (int r = 0; r < 4; ++r) {
        int d = w * 32 + dt * 16 + q * 4 + r;
#pragma unroll
        for (int vt = 0; vt < 8; ++vt) Uc[d * 128 + vt * 16 + lr] = acc[dt][vt][r];
        if (lr == 0) Un[d] = nacc[dt][r];
      }
    if (tid == 0) { Usc[0] = B_L; Usc[1] = B_L + amax; }
  }
}

template <int NC>
__device__ __forceinline__ void scan_chain(const Params& p, int l, int sl, int seq, int h, int dir, int tid) {
  char* ws = p.ws;
  const float* UcAll = (const float*)(ws + OFF_UC);
  const float* UnAll = (const float*)(ws + OFF_UN);
  const float* UscAll = (const float*)(ws + OFF_USC);
  bf16_t* ctt = (bf16_t*)(ws + OFF_CTT);
  float* nst = (float*)(ws + OFF_NST);
  float* mst = (float*)(ws + OFF_MST);
  constexpr bool lat = NC == 8;
  const int chunk0 = lat ? 32 + (seq - 16) * 8 : seq * 2;
  const int bidx = lat ? seq - 16 : seq;
  const int idx = sl * 256 + tid;
  const int v = idx & 127, d0 = (idx >> 7) * 8;
  const int sidx = ((bidx * 4 + l) * 2 + dir) * 4 + h;
  const bool do_n = (sl == 0) && (tid < 128);
  float u[NC][8], un[NC], Bv[NC], av[NC];
#pragma unroll
  for (int k = 0; k < NC; ++k) {
    const int j = dir == 0 ? k : NC - 1 - k;
    const int it = ((chunk0 + j) * 4 + h) * 2 + dir;
#pragma unroll
    for (int e = 0; e < 8; ++e) u[k][e] = UcAll[(size_t)it * 16384 + (d0 + e) * 128 + v];
    un[k] = do_n ? UnAll[(size_t)it * 128 + tid] : 0.f;
    Bv[k] = UscAll[it * 2]; av[k] = UscAll[it * 2 + 1];
  }
  float C[8];
#pragma unroll
  for (int e = 0; e < 8; ++e) { if (lat) C[e] = p.state_C[(size_t)sidx * 16384 + (d0 + e) * 128 + v]; else { float zz; asm volatile("v_mov_b32 %0, 0" : "=v"(zz)); C[e] = zz; } }
  float nv = (lat && do_n) ? p.state_n[(size_t)sidx * 128 + tid] : 0.f;
  float m = lat ? p.state_m[sidx] : 0.f;
#pragma unroll
  for (int k = 0; k < NC; ++k) {
    const int j = dir == 0 ? k : NC - 1 - k;
    const int it = ((chunk0 + j) * 4 + h) * 2 + dir;
    *(bf16x8*)(ctt + (size_t)it * 16384 + v * 128 + d0) = pack8((f32x4){C[0], C[1], C[2], C[3]}, (f32x4){C[4], C[5], C[6], C[7]});
    if (do_n) nst[(size_t)it * 128 + tid] = nv;
    if (idx == 0) mst[it] = m;
    const float mn = fmaxf(Bv[k] + m, av[k]);
    const float de = __expf(Bv[k] + m - mn), su = __expf(av[k] - mn);
#pragma unroll
    for (int e = 0; e < 8; ++e) C[e] = de * C[e] + su * u[k][e];
    nv = de * nv + su * un[k];
    m = mn;
  }
  if (!lat) {
#pragma unroll
    for (int e = 0; e < 8; ++e) p.out[O_SC + (size_t)sidx * 16384 + (d0 + e) * 128 + v] = C[e];
    if (do_n) p.out[O_SN + (size_t)sidx * 128 + tid] = nv;
    if (idx == 0) p.out[O_SM + sidx] = m;
  }
}
__device__ void scan_item(const Params& p, int l, int item) {
  const int sl = item & 7, c = item >> 3;
  const int dir = c & 1, h = (c >> 1) & 3, seq = c >> 3;
  const int tid = opaque_tid();
  if (seq >= 16) scan_chain<8>(p, l, sl, seq, h, dir, tid); else scan_chain<2>(p, l, sl, seq, h, dir, tid);
}

__device__ void mlh_item(const Params& p, int l, int item, char* lds) {
  char* ws = opaque_ptr(p.ws);
  const bf16_t* z = (const bf16_t*)(ws + OFF_Z);
  bf16_t* yml = (bf16_t*)(ws + OFF_YML);
  const bf16_t* mqc = (const bf16_t*)(ws + OFF_MQC);
  const bf16_t* mkc = (const bf16_t*)(ws + OFF_MKC);
  const int thalf = item & 1, h = (item >> 1) & 3, chunk = item >> 3;
  const int row0 = chunk * 128;
  const int tid = opaque_tid(), lane = tid & 63, w = tid >> 6, lr = lane & 15, q = lane >> 4;
  bf16_t* bufA = (bf16_t*)lds;
  bf16_t* bufB = (bf16_t*)(lds + 34816);
  float* fl = (float*)(lds + 69632);
  __syncthreads();
  {
    const float* gsrc = (const float*)(ws + OFF_GB) + (size_t)((chunk * 4 + h) * 2) * 384;
    for (int i = tid; i < 768; i += 256) {
      int dir = i / 384, r = i % 384;
      fl[(r >> 7) * 256 + dir * 128 + (r & 127)] = gsrc[i];
    }
    const bf16_t* vtt = (const bf16_t*)(ws + OFF_VTT) + (size_t)(chunk * 4 + h) * 16384;
#pragma unroll
    for (int i = 0; i < 8; ++i) {
      int idx = tid + i * 256;
      int s = idx >> 4, ch = idx & 15;
      *(bf16x8*)(bufA + s * 136 + ch * 8) = *(const bf16x8*)(mkc + (size_t)(row0 + s) * 512 + h * 128 + ch * 8);
      *(bf16x8*)(bufB + s * 136 + ch * 8) = *(const bf16x8*)(z + (size_t)(row0 + s) * ZW + MV + h * 128 + ch * 8);
    }
  }
  __syncthreads();
  const int t = thalf * 64 + w * 16 + lr;
  const float* mst = (const float*)(ws + OFF_MST);
  bf16x8 qf[4];
#pragma unroll
  for (int ks = 0; ks < 4; ++ks) qf[ks] = *(const bf16x8*)(mqc + (size_t)(row0 + t) * 512 + h * 128 + ks * 32 + q * 8);
  bf16x8 pf[2][4];
  float dens[2], mtt[2], sint[2];
  {
    f32x4 sa[8];
#pragma unroll
    for (int st = 0; st < 8; ++st) sa[st] = zero4();
#pragma unroll
    for (int ks = 0; ks < 4; ++ks) {
#pragma unroll
      for (int st = 0; st < 8; ++st) {
        bf16x8 kf = *(const bf16x8*)(bufA + (st * 16 + lr) * 136 + ks * 32 + q * 8);
        sa[st] = MFMA(kf, qf[ks], sa[st]);
      }
      __builtin_amdgcn_sched_barrier(0);
    }
#pragma unroll
    for (int dir = 0; dir < 2; ++dir) {
      const float mprev = mst[(chunk * 4 + h) * 2 + dir];
      const float bbt = fl[dir * 128 + t];
      const float mt_ = fmaxf(bbt + mprev, bbt + fl[512 + dir * 128 + t]);
      mtt[dir] = mt_;
      sint[dir] = __expf(bbt + mprev - mt_);
      const float bt = bbt - mt_;
      float dsum = 0.f;
      f32x4 pw[8];
#pragma unroll
      for (int st = 0; st < 8; ++st) {
        f32x4 cs = *(const f32x4*)(fl + 256 + dir * 128 + st * 16 + q * 4);
#pragma unroll
        for (int r = 0; r < 4; ++r) {
          int s = st * 16 + q * 4 + r;
          bool ok = dir == 0 ? (s <= t) : (s >= t);
          float wgt = ok ? __expf(bt + cs[r]) : 0.f;
          float pv = sa[st][r] * wgt;
          pw[st][r] = pv;
          dsum += pv;
        }
      }
      dens[dir] = dsum;
#pragma unroll
      for (int a = 0; a < 4; ++a) pf[dir][a] = pack8(pw[2 * a], pw[2 * a + 1]);
      __builtin_amdgcn_sched_barrier(0);
    }
  }
  f32x4 hsum[8];
  bf16x8 ctr[8];
  {
    const bf16_t* ctt0 = (const bf16_t*)(ws + OFF_CTT) + (size_t)((chunk * 4 + h) * 2) * 16384;
#pragma unroll
    for (int i = 0; i < 8; ++i) { int idx = tid + i * 256; ctr[i] = *(const bf16x8*)(ctt0 + (idx >> 4) * 128 + (idx & 15) * 8); }
  }
#pragma unroll
  for (int dir = 0; dir < 2; ++dir) {
    const int sitem = (chunk * 4 + h) * 2 + dir;
    const float* nvec = (const float*)(ws + OFF_NST) + (size_t)sitem * 128;
    __syncthreads();
#pragma unroll
    for (int i = 0; i < 8; ++i) { int idx = tid + i * 256; *(bf16x8*)(bufA + (idx >> 4) * 136 + (idx & 15) * 8) = ctr[i]; }
    if (dir == 0) {
      const bf16_t* ctt1 = (const bf16_t*)(ws + OFF_CTT) + (size_t)((chunk * 4 + h) * 2 + 1) * 16384;
#pragma unroll
      for (int i = 0; i < 8; ++i) { int idx = tid + i * 256; ctr[i] = *(const bf16x8*)(ctt1 + (idx >> 4) * 128 + (idx & 15) * 8); }
    }
    __syncthreads();
    f32x4 acc[8];
#pragma unroll
    for (int vt = 0; vt < 8; ++vt) acc[vt] = zero4();
    f32x4 qn = zero4();
    bf16x8 nfr[4];
#pragma unroll
    for (int ks = 0; ks < 4; ++ks) nfr[ks] = ld_f32x8_bf(nvec + ks * 32 + q * 8);
#pragma unroll
    for (int ks = 0; ks < 4; ++ks) {
      const bf16x8 nf = nfr[ks];
      qn = MFMA(nf, qf[ks], qn);
#pragma unroll
      for (int vt = 0; vt < 8; ++vt) {
        bf16x8 cf = *(const bf16x8*)(bufA + (vt * 16 + lr) * 136 + ks * 32 + q * 8);
        acc[vt] = MFMA(cf, qf[ks], acc[vt]);
      }
      __builtin_amdgcn_sched_barrier(0);
    }
#pragma unroll
    for (int vt = 0; vt < 8; ++vt) { acc[vt][0] *= sint[dir]; acc[vt][1] *= sint[dir]; acc[vt][2] *= sint[dir]; acc[vt][3] *= sint[dir]; }
#pragma unroll
    for (int a = 0; a < 4; ++a) {
#pragma unroll
      for (int vt = 0; vt < 8; ++vt) {
        const bf16_t* va0 = bufB + (a * 32 + q * 4 + (lr >> 2)) * 136 + vt * 16 + 4 * (lr & 3);
        bf16x4 v0 = lds_tr4(va0);
        bf16x4 v1 = lds_tr4(va0 + 16 * 136);
        acc[vt] = MFMA(cat4(v0, v1), pf[dir][a], acc[vt]);
      }
      __builtin_amdgcn_sched_barrier(0);
    }
    float ds = dens[dir];
    ds += __shfl_xor(ds, 16); ds += __shfl_xor(ds, 32);
    const float den = ds + sint[dir] * qn[0];
    const float inv = 1.f / fmaxf(fabsf(den), __expf(-mtt[dir]));
#pragma unroll
    for (int vt = 0; vt < 8; ++vt) {
      if (dir == 0) hsum[vt] = (f32x4){acc[vt][0] * inv, acc[vt][1] * inv, acc[vt][2] * inv, acc[vt][3] * inv};
      else { hsum[vt][0] += acc[vt][0] * inv; hsum[vt][1] += acc[vt][1] * inv; hsum[vt][2] += acc[vt][2] * inv; hsum[vt][3] += acc[vt][3] * inv; }
    }
  }
  {
    float ss = 0.f;
#pragma unroll
    for (int vt = 0; vt < 8; ++vt)
#pragma unroll
      for (int r = 0; r < 4; ++r) ss += hsum[vt][r] * hsum[vt][r];
    ss += __shfl_xor(ss, 16); ss += __shfl_xor(ss, 32);
    const float rstd = rsqrtf(ss * (1.f / 128.f) + 1e-6f);
#pragma unroll
    for (int vt = 0; vt < 8; ++vt) {
      int v = vt * 16 + q * 4;
      f32x4 g = *(const f32x4*)(p.ml_norm_g + l * 128 + v);
      bf16x4 og = *(const bf16x4*)(z + (size_t)(row0 + t) * ZW + MO + h * 128 + v);
      *(bf16x4*)(yml + (size_t)(row0 + t) * 512 + h * 128 + v) =
          pack4(bfs(og[0]) * hsum[vt][0] * rstd * g[0], bfs(og[1]) * hsum[vt][1] * rstd * g[1],
                bfs(og[2]) * hsum[vt][2] * rstd * g[2], bfs(og[3]) * hsum[vt][3] * rstd * g[3]);
    }
  }
}

__device__ void sg_item(const Params& p, int l, int item, char* lds) {
  char* ws = opaque_ptr(p.ws);
  const bf16_t* z = (const bf16_t*)(ws + OFF_Z);
  bf16_t* ysg = (bf16_t*)(ws + OFF_YSG);
  const int g = item & 3, chunk = item >> 2;
  const int row0 = chunk * 128;
  const int tid = opaque_tid(), lane = tid & 63, w = tid >> 6, lr = lane & 15, q = lane >> 4;
  bf16_t* svT = (bf16_t*)lds;
  float* mean = (float*)(lds + 34816);
  float* rstd = mean + 128;
  __syncthreads();
#pragma unroll 1
  for (int i0 = 0; i0 < 32; i0 += 8) {
    bf16x8 xr[8];
#pragma unroll
    for (int k = 0; k < 8; ++k) xr[k] = *(const bf16x8*)(z + (size_t)(row0 + w * 32 + i0 + k) * ZW + SV + lane * 8);
#pragma unroll
    for (int k = 0; k < 8; ++k) {
      const int t = w * 32 + i0 + k;
      const bf16x8 xv = xr[k];
      float s = 0.f;
#pragma unroll
      for (int e = 0; e < 8; ++e) s += bfs(xv[e]);
#pragma unroll
      for (int of = 1; of < 64; of <<= 1) s += __shfl_xor(s, of);
      float mu = s * (1.f / 512.f);
      float v2 = 0.f;
#pragma unroll
      for (int e = 0; e < 8; ++e) { float d = bfs(xv[e]) - mu; v2 += d * d; }
#pragma unroll
      for (int of = 1; of < 64; of <<= 1) v2 += __shfl_xor(v2, of);
      if (lane == 0) { mean[t] = mu; rstd[t] = rsqrtf(v2 * (1.f / 512.f) + 1e-6f); }
    }
  }
  __syncthreads();
#pragma unroll 4
  for (int i = 0; i < 8; ++i) {
    const int idx = tid + i * 256;
    const int s = idx >> 4, cch = idx & 15;
    const float mu = mean[s], rs = rstd[s];
    bf16x8 xv = *(const bf16x8*)(z + (size_t)(row0 + s) * ZW + SV + g * 128 + cch * 8);
    const float* gn = p.sg_norm_g + l * 512 + g * 128 + cch * 8;
    float nv[8];
#pragma unroll
    for (int e = 0; e < 8; ++e) nv[e] = (bfs(xv[e]) - mu) * rs * gn[e];
    *(bf16x8*)(svT + s * 136 + cch * 8) = pack8((f32x4){nv[0], nv[1], nv[2], nv[3]}, (f32x4){nv[4], nv[5], nv[6], nv[7]});
  }
  __syncthreads();
  f32x4 acc[8][2];
#pragma unroll
  for (int ct = 0; ct < 8; ++ct)
#pragma unroll
    for (int pt = 0; pt < 2; ++pt) acc[ct][pt] = zero4();
#pragma unroll
  for (int ks = 0; ks < 4; ++ks) {
    bf16x8 wf[2];
#pragma unroll
    for (int pt = 0; pt < 2; ++pt) { int rowi = w * 32 + pt * 16 + lr; asm volatile("" : "+v"(rowi)); wf[pt] = ld_f32x8_bf(p.sg_w + ((size_t)(l * 4 + g) * 128 + rowi) * 128 + ks * 32 + q * 8); }
#pragma unroll
    for (int ct = 0; ct < 8; ++ct) {
      const bf16_t* sa_ = svT + (ks * 32 + q * 8 + (lr >> 2)) * 136 + ct * 16 + 4 * (lr & 3);
      bf16x8 sf = cat4(lds_tr4(sa_), lds_tr4(sa_ + 4 * 136));
#pragma unroll
      for (int pt = 0; pt < 2; ++pt) acc[ct][pt] = MFMA(sf, wf[pt], acc[ct][pt]);
    }
    __builtin_amdgcn_sched_barrier(0);
  }
#pragma unroll
  for (int pt = 0; pt < 2; ++pt) {
    int pp = w * 32 + pt * 16 + lr;
    float bias = p.sg_b[(l * 4 + g) * 128 + pp];
#pragma unroll
    for (int ct = 0; ct < 8; ++ct) {
      int c = g * 128 + ct * 16 + q * 4;
      bf16x4 u = *(const bf16x4*)(z + (size_t)(row0 + pp) * ZW + SU + c);
      *(bf16x4*)(ysg + (size_t)(row0 + pp) * 512 + c) =
          pack4(bfs(u[0]) * (acc[ct][pt][0] + bias), bfs(u[1]) * (acc[ct][pt][1] + bias), bfs(u[2]) * (acc[ct][pt][2] + bias), bfs(u[3]) * (acc[ct][pt][3] + bias));
    }
  }
}

__device__ void phase_merge(const Params& p, int l, char* lds) {
  char* ws = opaque_ptr(p.ws);
  const bf16_t* z = (const bf16_t*)(ws + OFF_Z);
  bf16_t* mrg = (bf16_t*)(ws + OFF_MRG);
  const int tid = opaque_tid(), lane = tid & 63, w = tid >> 6, wm = w >> 1, wn = w & 1, lr = lane & 15, q = lane >> 4;
  for (int it = VBLK; it < 64 * 8; it += VGRID) {
    const int nt = it >> 6, mt = it & 63;
    const int m0 = mt * 128, n0 = nt * 128;
    f32x4 macc[4][4];
    zero_acc(macc);
#pragma unroll 1
    for (int br = 0; br < 3; ++br) {
      f32x4 acc[4][4];
      zero_acc(acc);
      const bf16_t* A = (const bf16_t*)(ws + OFF_YDA) + (size_t)br * NTOK * 512;
      const bf16_t* Bt = (const bf16_t*)(ws + OFF_WBR) + (size_t)(l * 3 + br) * 1024 * 512;
      gemm_mainloop(p, acc, A, 512, Bt, 512, m0, n0, 512, lds);
#pragma unroll
      for (int mi = 0; mi < 4; ++mi) {
        int m = m0 + wm * 64 + mi * 16 + lr;
        const bf16_t* gp_ = z + (size_t)m * ZW + GT + br * 1024 + n0 + wn * 64 + q * 4;
#pragma unroll
        for (int ni = 0; ni < 4; ++ni) {
          bf16x4 g = *(const bf16x4*)(gp_ + ni * 16);
          macc[mi][ni][0] += bfs(g[0]) * acc[mi][ni][0]; macc[mi][ni][1] += bfs(g[1]) * acc[mi][ni][1];
          macc[mi][ni][2] += bfs(g[2]) * acc[mi][ni][2]; macc[mi][ni][3] += bfs(g[3]) * acc[mi][ni][3];
        }
      }
    }
#pragma unroll
    for (int mi = 0; mi < 4; ++mi) {
      int m = m0 + wm * 64 + mi * 16 + lr;
      bf16_t* rowp = mrg + (size_t)m * 1024 + n0 + wn * 64 + q * 4;
#pragma unroll
      for (int ni = 0; ni < 4; ++ni) *(bf16x4*)(rowp + ni * 16) = pack4(macc[mi][ni][0], macc[mi][ni][1], macc[mi][ni][2], macc[mi][ni][3]);
    }
  }
}

__device__ void phase_resid(const Params& p, int l, int second, char* lds) {
  char* ws = opaque_ptr(p.ws);
  const bf16_t* A = (const bf16_t*)(ws + (second ? OFF_ACT : OFF_MRG));
  const int K = second ? DFF : 1024;
  const bf16_t* Bt = second ? (const bf16_t*)(ws + OFF_WDN) + (size_t)l * 1024 * DFF : (const bf16_t*)(ws + OFF_WOUT) + (size_t)l * 1024 * 1024;
  const int gate_off = second ? 5120 : 2048;
  const bool has_next = !(second && l == 3);
  bf16_t* anext = (bf16_t*)(ws + (second ? OFF_A1 : OFF_H));
  const int sc_layer = second ? (l < 3 ? l + 1 : l) : l;
  const int sc_off = second ? 1024 : 4096;
  float* x = (float*)(ws + OFF_X);
  float* ssp = (float*)(ws + OFF_SSP);
  const float* mod = (const float*)(ws + OFF_MOD);
  const int tid = opaque_tid(), lane = tid & 63, w = tid >> 6, wm = w >> 1, wn = w & 1, lr = lane & 15, q = lane >> 4;
  for (int it = VBLK; it < 64 * 8; it += VGRID) {
    const int nt = it >> 6, mt = it & 63;
    const int m0 = mt * 128, n0 = nt * 128;
    f32x4 acc[4][4];
    zero_acc(acc);
    gemm_mainloop(p, acc, A, K, Bt, K, m0, n0, K, lds);
    const int cnd = cond_of(m0);
    const float* grow = mod + (size_t)(l * 5 + cnd) * 6144 + gate_off + n0 + wn * 64 + q * 4;
    const float* scrow = mod + (size_t)(sc_layer * 5 + cnd) * 6144 + sc_off + n0 + wn * 64 + q * 4;
    float* ssl = (float*)lds;
    float ssk[4];
#pragma unroll
    for (int mi = 0; mi < 4; ++mi) {
      int m = m0 + wm * 64 + mi * 16 + lr;
      float* rowp = x + (size_t)m * 1024 + n0 + wn * 64 + q * 4;
      float ss = 0.f;
#pragma unroll
      for (int ni = 0; ni < 4; ++ni) {
        f32x4 g = *(const f32x4*)(grow + ni * 16);
        f32x4 xv = *(const f32x4*)(rowp + ni * 16);
        xv[0] += g[0] * acc[mi][ni][0]; xv[1] += g[1] * acc[mi][ni][1]; xv[2] += g[2] * acc[mi][ni][2]; xv[3] += g[3] * acc[mi][ni][3];
        *(f32x4*)(rowp + ni * 16) = xv;
        ss += xv[0] * xv[0] + xv[1] * xv[1] + xv[2] * xv[2] + xv[3] * xv[3];
        if (has_next) {
          f32x4 sc = *(const f32x4*)(scrow + ni * 16);
          *(bf16x4*)(anext + (size_t)m * 1024 + n0 + wn * 64 + q * 4 + ni * 16) = pack4(xv[0] * (1.f + sc[0]), xv[1] * (1.f + sc[1]), xv[2] * (1.f + sc[2]), xv[3] * (1.f + sc[3]));
        }
      }
      ss += __shfl_xor(ss, 16); ss += __shfl_xor(ss, 32);
      if (q == 0 && wn == 1) ssl[wm * 64 + mi * 16 + lr] = ss;
      ssk[mi] = ss;
    }
    __syncthreads();
    if (wn == 0 && q == 0) {
#pragma unroll
      for (int mi = 0; mi < 4; ++mi) ssp[(size_t)nt * NTOK + m0 + wm * 64 + mi * 16 + lr] = ssk[mi] + ssl[wm * 64 + mi * 16 + lr];
    }
    __syncthreads();
  }
}

__device__ void phase_up(const Params& p, int l, char* lds_all) {
  char* ws = opaque_ptr(p.ws);
  const bf16_t* H = (const bf16_t*)(ws + OFF_H);
  const bf16_t* Wt = (const bf16_t*)(ws + OFF_WUP) + (size_t)l * UW * 1024;
  bf16_t* u = (bf16_t*)(ws + OFF_U);
  int tid = real_tid_(p.wave);
  const int lane = tid & 63, w = tid >> 6, wm = w >> 2, wn = w & 3, lr = lane & 15, q = lane >> 4;
  float* rs_lds = (float*)(lds_all + 131072);
  float* sh_lds = (float*)(lds_all + 131072 + 1024);
  int par = 0, cur_mt = -1;
  for (int it = blockIdx.x; it < 32 * 22; it += gridDim.x, par ^= 1) {
    const int ntw = it >> 5, mt = it & 31;
    const int m0 = mt * 256, n0 = ntw * 256;
    if (mt != cur_mt) {
      __syncthreads();
      if (tid < 256) rs_lds[tid] = row_rstd((const float*)(ws + OFF_SSP), m0 + tid);
      cur_mt = mt;
    }
    if (tid < 64) *(f32x4*)(sh_lds + par * 256 + tid * 4) = *(const f32x4*)((const float*)(ws + OFF_SHW2) + (size_t)(l * 5 + cond_of(m0)) * UW + n0 + tid * 4);
    f32x4 acc[8][4];
#pragma unroll
    for (int i = 0; i < 8; ++i)
#pragma unroll
      for (int j = 0; j < 4; ++j) acc[i][j] = zero4();
    gemm_mainloop_8w(acc, H, 1024, Wt, 1024, m0, n0, 1024, lds_all, p.wave);
    int lro = lr; asm volatile("" : "+v"(lro));
    const float* shl = sh_lds + par * 256 + wn * 64 + q * 4;
    char* stg = lds_all + w * 8192;
#pragma unroll
    for (int mh = 0; mh < 2; ++mh) {
#pragma unroll
      for (int mq = 0; mq < 4; ++mq) {
        const int mi = mh * 4 + mq;
        const float rs = rs_lds[wm * 128 + mi * 16 + lro];
#pragma unroll
        for (int ni = 0; ni < 4; ++ni) {
          f32x4 sv = *(const f32x4*)(shl + ni * 16);
          *(bf16x4*)(stg + (mq * 16 + lro) * 128 + ((((ni << 1) | (q >> 1)) ^ (lro & 7)) << 4) + ((q & 1) << 3)) =
              pack4(acc[mi][ni][0] * rs + sv[0], acc[mi][ni][1] * rs + sv[1], acc[mi][ni][2] * rs + sv[2], acc[mi][ni][3] * rs + sv[3]);
        }
      }
#pragma unroll
      for (int i = 0; i < 8; ++i) {
        const int r = i * 8 + (lane >> 3), c = lane & 7;
        bf16x8 v = *(const bf16x8*)(stg + r * 128 + ((c ^ (r & 7)) << 4));
        *(bf16x8*)(u + (size_t)(m0 + wm * 128 + mh * 64 + r) * UW + n0 + wn * 64 + c * 8) = v;
      }
    }
    __syncthreads();
  }
}

__device__ void phase_act(const Params& p, int l) {
  char* ws = opaque_ptr(p.ws);
  const bf16_t* u = (const bf16_t*)(ws + OFF_U);
  bf16_t* act = (bf16_t*)(ws + OFF_ACT);
  const float* cw = p.ffn_conv_w + (size_t)l * 3 * UW;
  const float* cb = p.ffn_conv_b + (size_t)l * UW;
  const int tid = opaque_tid();
  constexpr int RPT = 8;
  const int total = (NTOK / RPT) * 352;
  for (int idx = VBLK * 256 + tid; idx < total; idx += VGRID * 256) {
    const int rg = idx / 352, kc = idx - rg * 352;
    const int mbase = rg * RPT;
    const int T = mbase < NCTX ? 256 : 1024;
    const int tp0 = mbase < NCTX ? (mbase & 255) : ((mbase - NCTX) & 1023);
    const int ca = kc * 8, cbb = DFF + kc * 8;
    float wa[3][8], wb[3][8], ba[8], bb[8];
#pragma unroll
    for (int t = 0; t < 3; ++t) {
      f32x4 x0 = *(const f32x4*)(cw + t * UW + ca), x1 = *(const f32x4*)(cw + t * UW + ca + 4);
      f32x4 y0 = *(const f32x4*)(cw + t * UW + cbb), y1 = *(const f32x4*)(cw + t * UW + cbb + 4);
#pragma unroll
      for (int e = 0; e < 4; ++e) { wa[t][e] = x0[e]; wa[t][4 + e] = x1[e]; wb[t][e] = y0[e]; wb[t][4 + e] = y1[e]; }
    }
    {
      f32x4 x0 = *(const f32x4*)(cb + ca), x1 = *(const f32x4*)(cb + ca + 4), y0 = *(const f32x4*)(cb + cbb), y1 = *(const f32x4*)(cb + cbb + 4);
#pragma unroll
      for (int e = 0; e < 4; ++e) { ba[e] = x0[e]; ba[4 + e] = x1[e]; bb[e] = y0[e]; bb[4 + e] = y1[e]; }
    }
    const bf16_t* up = u + (size_t)mbase * UW + kc * 8;
    bf16x8 a0 = zero8(), b0 = zero8();
    if (tp0 > 0) { a0 = *(const bf16x8*)(up - UW); b0 = *(const bf16x8*)(up - UW + DFF); }
    bf16x8 a1 = *(const bf16x8*)up, b1 = *(const bf16x8*)(up + DFF);
#pragma unroll
    for (int r = 0; r < RPT; ++r) {
      bf16x8 a2 = zero8(), b2 = zero8();
      if (tp0 + r < T - 1) { a2 = *(const bf16x8*)(up + (size_t)(r + 1) * UW); b2 = *(const bf16x8*)(up + (size_t)(r + 1) * UW + DFF); }
      float ov[8];
#pragma unroll
      for (int e = 0; e < 8; ++e) {
        float c1 = wa[0][e] * bfs(a0[e]) + wa[1][e] * bfs(a1[e]) + wa[2][e] * bfs(a2[e]) + ba[e];
        float c2 = wb[0][e] * bfs(b0[e]) + wb[1][e] * bfs(b1[e]) + wb[2][e] * bfs(b2[e]) + bb[e];
        ov[e] = siluf(c1) * c2;
      }
      *(bf16x8*)(act + (size_t)(mbase + r) * DFF + kc * 8) = pack8((f32x4){ov[0], ov[1], ov[2], ov[3]}, (f32x4){ov[4], ov[5], ov[6], ov[7]});
      a0 = a1; a1 = a2; b0 = b1; b1 = b2;
    }
  }
}

__global__ void __launch_bounds__(512, 2) trunk_megakernel(Params p_in) {
  Params p = p_in;
  p.wave = __builtin_amdgcn_readfirstlane((int)(threadIdx.x >> 6));
  extern __shared__ __attribute__((aligned(16))) char lds_all[];
  char* lds = lds_all + VHALF * VLDS;
  cg::grid_group grid = cg::this_grid();
  char* ws = p.ws;
  if (p.never) grid.sync();
  volatile LAS unsigned* xst = (volatile LAS unsigned*)(lds_all + LDS_BYTES - 16);
  if (threadIdx.x == 0) { xst[0] = 0u; xst[1] = 0u; xst[2] = 0u; xst[3] = 0u; }
  __syncthreads();
  XcdBarrier xb = xcd_barrier_post((unsigned*)(ws + OFF_BAR), xst);
  for (int ph = p.phase_begin; ph < p.phase_end; ++ph) {
    if (ph > p.phase_begin) { xcd_barrier(xb);
#ifdef SYNC_REP
      xcd_barrier(xb); xcd_barrier(xb);
#endif
    }
    if (ph == 0) { phase_prologue(p, lds); continue; }
    if (ph == 1) { phase_init(p); continue; }
    if (ph == 38) { phase_norm(p, 0, 2, false); continue; }
    const int l = (ph - 2) / 9, sp = (ph - 2) % 9;
    const int G = VGRID;
    for (int rep = 0; rep < (((p.rep_mask >> sp) & 1) ? 2 : 1); ++rep) {
    if (rep) xcd_barrier(xb);
    switch (sp) {
      case 0: phase_inproj(p, l, lds_all); break;
      case 1: case 2: {
        const int G1 = G >> 1, G2 = G - G1;
        if (sp == 1) {
          if (VBLK < G1) { for (int it = VBLK; it < 256; it += G1) { mlu_item(p, l, it, lds); __syncthreads(); } }
          else for (int it = VBLK - G1; it < 256; it += G2) { sg_item(p, l, it, lds); __syncthreads(); }
        }
        int it0, itN, step, split;
        if (sp == 1) { it0 = (VBLK >= G1) ? 256 + (VBLK - G1) : 512; itN = 512; step = G2; split = 0; }
        else { it0 = blockIdx.x; itN = 256; step = gridDim.x; split = 1; }
        for (int it = it0; it < itN; it += step) { attn_item(p, l, it, lds, split, lds_all); __syncthreads(); }
        if (sp == 2) for (int it = VBLK; it < 1280; it += G) scan_item(p, l, it);
      } break;
      case 3:
        for (int it = VBLK; it < 512; it += G) { mlh_item(p, l, it, lds); __syncthreads(); }
        break;
      case 4: phase_merge(p, l, lds); break;
      case 5: case 8: phase_resid(p, l, sp == 8, lds); break;
      case 6: phase_up(p, l, lds_all); break;
      case 7: phase_act(p, l); break;
    }
    }
  }
}

extern "C" void kernel_launch(void* const* d_in, const int* in_sizes, int n_in, void* d_out, int out_size, void* d_ws, size_t ws_size,
                              hipStream_t stream) {
  static int grid_blocks = 0;
  if (!grid_blocks) {
    int dev = 0, cus = 0, per_cu = 0;
    hipGetDevice(&dev);
    hipDeviceGetAttribute(&cus, hipDeviceAttributeMultiprocessorCount, dev);
    hipFuncSetAttribute((const void*)trunk_megakernel, hipFuncAttributeMaxDynamicSharedMemorySize, LDS_BYTES);
    hipOccupancyMaxActiveBlocksPerMultiprocessor(&per_cu, trunk_megakernel, 512, LDS_BYTES);
    per_cu = 1;
    grid_blocks = cus * per_cu;
  }
  if (ws_size < WS_NEED) { fprintf(stderr, "workspace too small: %zu < %zu\n", ws_size, (size_t)WS_NEED); return; }
  Params p{};
  const float** f = (const float**)&p;
  for (int i = 0; i < 28; ++i) f[i] = (const float*)d_in[i];
  p.out = (float*)d_out;
  p.ws = (char*)d_ws;
  p.phase_begin = 0;
  p.phase_end = 39;
  p.rep_mask = REP_MASK;
  hipMemsetAsync((char*)d_ws + OFF_BAR, 0, 16384, stream);
  void* args[] = {&p};
  hipError_t e = hipLaunchCooperativeKernel((const void*)trunk_megakernel, dim3(grid_blocks), dim3(512), args, LDS_BYTES, stream);
  if (e != hipSuccess) fprintf(stderr, "cooperative launch failed: %s (grid %d)\n", hipGetErrorString(e), grid_blocks);
}
```
